# Optimizing an MI355X kernel written in HIP

```python
import jax, jax.numpy as jnp
from jax import lax
import numpy as np

D_MODEL = 1024
BATCH = 4
SEQ = 8192
DEPTH = 2
DEC_BATCH = 32
DEC_SEQ = 2048
PAST_LEN = 128

GRID_W = 64
N_HEADS = 8
HEAD_DIM = 64
ATTN_WIDTH = N_HEADS * HEAD_DIM
CONV_WIDTH = D_MODEL - ATTN_WIDTH
WIN_H_MAX = 8
WIN_W = 16
Q_COL_BLOCK = 16
K_COL_BLOCK = Q_COL_BLOCK + WIN_W
D_FF = 2816
PROJ_WIDTH = 3 * ATTN_WIDTH + 3 * CONV_WIDTH + 2 * D_MODEL
DEEPNORM_ALPHA = (2 * DEPTH) ** 0.25
DEEPNORM_BETA = (8 * DEPTH) ** -0.25
LN_EPS = 1e-5

kernel_name = 'hybrid_natten_shortconv_deepnorm_encoder'


def layer_norm(x, g, b):
    xf = x.astype(jnp.float32)
    mu = jnp.mean(xf, axis=-1, keepdims=True)
    var = jnp.mean(jnp.square(xf - mu), axis=-1, keepdims=True)
    y = (xf - mu) * lax.rsqrt(var + LN_EPS)
    return (y * g.astype(jnp.float32) + b.astype(jnp.float32)).astype(x.dtype)


def dwconv3(x, w, b):
    xp = jnp.pad(x, ((0, 0), (1, 1), (0, 0)))
    return xp[:, :-2] * w[0] + xp[:, 1:-1] * w[1] + xp[:, 2:] * w[2] + b


def neighbourhood_attention(q, k, v, rpb):
    B, T, H, dh = q.shape
    rows = T // GRID_W
    kh = min(WIN_H_MAX, rows)
    scale = dh ** -0.5
    qg = q.reshape(B, rows, GRID_W, H, dh)
    kg = k.reshape(B, rows, GRID_W, H, dh)
    vg = v.reshape(B, rows, GRID_W, H, dh)
    row_starts = jnp.clip(jnp.arange(rows) - kh // 2, 0, rows - kh)

    def one_row(args):
        i, rs = args
        q_i = lax.dynamic_index_in_dim(qg, i, axis=1, keepdims=False)
        k_i = lax.dynamic_slice_in_dim(kg, rs, kh, axis=1)
        v_i = lax.dynamic_slice_in_dim(vg, rs, kh, axis=1)
        dr_idx = rs + jnp.arange(kh) - i + (WIN_H_MAX - 1)
        outs = []
        for c in range(GRID_W // Q_COL_BLOCK):
            q0 = c * Q_COL_BLOCK
            cs = min(max(q0 - WIN_W // 2, 0), GRID_W - K_COL_BLOCK)
            qj = jnp.arange(q0, q0 + Q_COL_BLOCK)
            kj = jnp.arange(cs, cs + K_COL_BLOCK)
            js = jnp.clip(qj - WIN_W // 2, 0, GRID_W - WIN_W)
            valid = (kj[None, :] >= js[:, None]) & (kj[None, :] < js[:, None] + WIN_W)
            dc_idx = jnp.clip(kj[None, :] - qj[:, None] + (WIN_W - 1), 0, 2 * WIN_W - 2)
            bias = rpb[:, dr_idx[None, :, None], dc_idx[:, None, :]]
            qc = q_i[:, q0:q0 + Q_COL_BLOCK]
            kc = k_i[:, :, cs:cs + K_COL_BLOCK]
            vc = v_i[:, :, cs:cs + K_COL_BLOCK]
            s = jnp.einsum('bqhd,brkhd->bhqrk', qc, kc).astype(jnp.float32) * scale
            s = s + bias.astype(jnp.float32)
            s = jnp.where(valid[:, None, :], s, -jnp.inf)
            p = jax.nn.softmax(s.reshape(B, H, Q_COL_BLOCK, kh * K_COL_BLOCK), axis=-1)
            p = p.astype(v.dtype).reshape(B, H, Q_COL_BLOCK, kh, K_COL_BLOCK)
            outs.append(jnp.einsum('bhqrk,brkhd->bqhd', p, vc))
        return jnp.concatenate(outs, axis=1)

    o = lax.map(one_row, (jnp.arange(rows), row_starts))
    return jnp.moveaxis(o, 0, 1).reshape(B, T, H * dh)


def encoder_layer(x, w_in, b_in, attn_rpb, sc_conv_w, sc_conv_b, w_br_attn, w_br_conv,
                  w_o, b_o, ln1_g, ln1_b, ffn_w_up, ffn_b_up, ffn_conv_w, ffn_conv_b,
                  ffn_w_down, ffn_b_down, ln2_g, ln2_b):
    B, T, _ = x.shape
    proj = x @ w_in + b_in
    splits = np.cumsum([ATTN_WIDTH, ATTN_WIDTH, ATTN_WIDTH, CONV_WIDTH, CONV_WIDTH,
                        CONV_WIDTH, D_MODEL]).tolist()
    q, k, v, u, gb_in, gc_in, gate_a, gate_c = jnp.split(proj, splits, axis=-1)
    ya = neighbourhood_attention(q.reshape(B, T, N_HEADS, HEAD_DIM),
                                 k.reshape(B, T, N_HEADS, HEAD_DIM),
                                 v.reshape(B, T, N_HEADS, HEAD_DIM), attn_rpb)
    yc = gb_in * dwconv3(gc_in * u, sc_conv_w, sc_conv_b)
    merged = jax.nn.sigmoid(gate_a) * (ya @ w_br_attn) + jax.nn.sigmoid(gate_c) * (yc @ w_br_conv)
    mix = merged @ w_o + b_o
    x = layer_norm(DEEPNORM_ALPHA * x + mix, ln1_g, ln1_b)
    h = dwconv3(x @ ffn_w_up + ffn_b_up, ffn_conv_w, ffn_conv_b)
    h_gate, h_val = jnp.split(h, 2, axis=-1)
    f = (jax.nn.gelu(h_gate) * h_val) @ ffn_w_down + ffn_b_down
    return layer_norm(DEEPNORM_ALPHA * x + f, ln2_g, ln2_b)


def trunk(x, w_in, b_in, attn_rpb, sc_conv_w, sc_conv_b, w_br_attn, w_br_conv, w_o, b_o,
          ln1_g, ln1_b, ffn_w_up, ffn_b_up, ffn_conv_w, ffn_conv_b, ffn_w_down, ffn_b_down,
          ln2_g, ln2_b):
    for l in range(DEPTH):
        x = encoder_layer(x, w_in[l], b_in[l], attn_rpb[l], sc_conv_w[l], sc_conv_b[l],
                          w_br_attn[l], w_br_conv[l], w_o[l], b_o[l], ln1_g[l], ln1_b[l],
                          ffn_w_up[l], ffn_b_up[l], ffn_conv_w[l], ffn_conv_b[l],
                          ffn_w_down[l], ffn_b_down[l], ln2_g[l], ln2_b[l])
    return x


def setup_inputs(seed: int = 0) -> dict:
    key = jax.random.key(seed)
    ks = jax.random.split(key, 22)
    nrm = lambda k, s: jax.random.normal(k, s, dtype=jnp.float32)
    beta = DEEPNORM_BETA
    col_scale = jnp.concatenate([
        jnp.ones((2 * ATTN_WIDTH,), jnp.float32),
        jnp.full((ATTN_WIDTH,), beta, jnp.float32),
        jnp.ones((3 * CONV_WIDTH + 2 * D_MODEL,), jnp.float32)])
    return {
        'x_prompt': nrm(ks[0], (BATCH, SEQ, D_MODEL)),
        'x_sample': nrm(ks[1], (DEC_BATCH, DEC_SEQ, D_MODEL)),
        'w_in': nrm(ks[2], (DEPTH, D_MODEL, PROJ_WIDTH)) * (D_MODEL ** -0.5) * col_scale,
        'b_in': 0.02 * nrm(ks[3], (DEPTH, PROJ_WIDTH)),
        'attn_rpb': 0.02 * nrm(ks[4], (DEPTH, N_HEADS, 2 * WIN_H_MAX - 1, 2 * WIN_W - 1)),
        'sc_conv_w': nrm(ks[5], (DEPTH, 3, CONV_WIDTH)) * (3 ** -0.5),
        'sc_conv_b': 0.02 * nrm(ks[6], (DEPTH, CONV_WIDTH)),
        'w_br_attn': nrm(ks[7], (DEPTH, ATTN_WIDTH, D_MODEL)) * (ATTN_WIDTH ** -0.5) * beta,
        'w_br_conv': nrm(ks[8], (DEPTH, CONV_WIDTH, D_MODEL)) * (CONV_WIDTH ** -0.5) * beta,
        'w_o': nrm(ks[9], (DEPTH, D_MODEL, D_MODEL)) * (D_MODEL ** -0.5) * beta,
        'b_o': 0.02 * nrm(ks[10], (DEPTH, D_MODEL)),
        'ln1_g': 1.0 + 0.01 * nrm(ks[11], (DEPTH, D_MODEL)),
        'ln1_b': 0.01 * nrm(ks[12], (DEPTH, D_MODEL)),
        'ffn_w_up': nrm(ks[13], (DEPTH, D_MODEL, 2 * D_FF)) * (D_MODEL ** -0.5) * beta,
        'ffn_b_up': 0.02 * nrm(ks[14], (DEPTH, 2 * D_FF)),
        'ffn_conv_w': nrm(ks[15], (DEPTH, 3, 2 * D_FF)) * (3 ** -0.5),
        'ffn_conv_b': 0.02 * nrm(ks[16], (DEPTH, 2 * D_FF)),
        'ffn_w_down': nrm(ks[17], (DEPTH, D_FF, D_MODEL)) * (D_FF ** -0.5) * beta,
        'ffn_b_down': 0.02 * nrm(ks[18], (DEPTH, D_MODEL)),
        'ln2_g': 1.0 + 0.01 * nrm(ks[19], (DEPTH, D_MODEL)),
        'ln2_b': 0.01 * nrm(ks[20], (DEPTH, D_MODEL)),
    }


def reference(x_prompt, x_sample, w_in, b_in, attn_rpb, sc_conv_w, sc_conv_b, w_br_attn,
              w_br_conv, w_o, b_o, ln1_g, ln1_b, ffn_w_up, ffn_b_up, ffn_conv_w, ffn_conv_b,
              ffn_w_down, ffn_b_down, ln2_g, ln2_b):
    y_prompt = trunk(x_prompt, w_in, b_in, attn_rpb, sc_conv_w, sc_conv_b, w_br_attn,
                     w_br_conv, w_o, b_o, ln1_g, ln1_b, ffn_w_up, ffn_b_up, ffn_conv_w,
                     ffn_conv_b, ffn_w_down, ffn_b_down, ln2_g, ln2_b)
    y_sample = trunk(x_sample, w_in, b_in, attn_rpb, sc_conv_w, sc_conv_b, w_br_attn,
                     w_br_conv, w_o, b_o, ln1_g, ln1_b, ffn_w_up, ffn_b_up, ffn_conv_w,
                     ffn_conv_b, ffn_w_down, ffn_b_down, ln2_g, ln2_b)
    return (y_prompt, y_sample)
```

```cpp
#include <hip/hip_runtime.h>
#include <hip/hip_cooperative_groups.h>
#include <cstdio>
#include <cstdint>
namespace cg = cooperative_groups;
namespace pg8 {
#define PG8_LAS __attribute__((address_space(3)))
typedef unsigned short bf16_t;
typedef short bf16x8 __attribute__((ext_vector_type(8)));
typedef float f32x4 __attribute__((ext_vector_type(4)));
typedef unsigned u32x4 __attribute__((ext_vector_type(4)));
constexpr int BM = 256, BK = 64, HALF = 128, HTB = HALF * BK * 2  , STAGE_BYTES = 8 * HTB, NXCD = 8, WGM = 8;

__host__ __device__ __forceinline__ int lds_byte(int r, int c) { const int st = (r >> 4) * 2 + (c >> 5), rr = r & 15, cc = c & 31, ob = rr * 64 + cc * 2; return st * 1024 + (ob ^ (((ob >> 9) & 1) << 5)); }
__host__ __device__ __forceinline__ void stage_rc(int b, int& R, int& C) { const int st = b / 1024, sb = b % 1024, swz = sb ^ (((sb >> 9) & 1) << 5); R = (st >> 1) * 16 + swz / 64; C = (st & 1) * 32 + (swz % 64) / 2; }
__host__ __device__ __forceinline__ int perm32(int rho) { const int n = rho >> 4, i = rho & 15; return 8 * (i >> 2) + 4 * n + (i & 3); }

struct Unit { int pm, pn, part; };
struct Gemm { const bf16_t* A; const bf16_t* Bt; int M, N, K, lda, ldb; const bf16_t* A2; const bf16_t* Bt2; };

struct StaticOrder {
    int nM, nN, nwg, G, c;
    __host__ __device__ void init(int M, int N, int G_, int c_) { nM = M / BM; nN = N / BM; nwg = nM * nN; G = G_; c = c_; }
    __host__ __device__ bool next(int i, Unit& u) const {
        const long L = (long)i * G + c; if (L >= nwg) return false;
        int wgid = (int)L; { const int q = nwg / NXCD, r = nwg % NXCD, xcd = wgid % NXCD, off = wgid / NXCD; wgid = (xcd < r ? xcd * (q + 1) : r * (q + 1) + (xcd - r) * q) + off; }
        const int nig = WGM * nN, gid = wgid / nig, fm = gid * WGM, gsz = (nM - fm) < WGM ? (nM - fm) : WGM;
        u.pm = fm + ((wgid % nig) % gsz); u.pn = (wgid % nig) / gsz; u.part = 0; return true;
    }
    __device__ __forceinline__ void a_ready(const Unit&) const {}
    __device__ __forceinline__ void done(const Unit&) const {}
};

__device__ __forceinline__ unsigned cvt_pk_bf16(float lo, float hi) { unsigned r; asm volatile("v_cvt_pk_bf16_f32 %0, %1, %2" : "=v"(r) : "v"(lo), "v"(hi)); return r; }
typedef float f32x2 __attribute__((ext_vector_type(2)));
template <class Epi, class Sched, bool ALIGN_EPI = false, bool SP2 = false>
__device__ __forceinline__ void gemm_phase(PG8_LAS unsigned char* lds, const Gemm g, const Sched& S, const Epi& E) {
    int tid_ = threadIdx.x; asm volatile("" : "+v"(tid_));
    const int tid = tid_, wid = __builtin_amdgcn_readfirstlane(tid >> 6), lane = tid & 63, wr = wid >> 2, wc = wid & 3, fr = lane & 15, fq = lane >> 4;
    const int K = g.K, nt = K / BK;
    unsigned voffA[2], voffB[2];
#pragma unroll
    for (int i = 0; i < 2; ++i) { int R, C; stage_rc(tid * 16 + i * 8192, R, C); const int Rb = Epi::PERM ? ((R & ~31) + perm32(R & 31)) : R;
        voffA[i] = (unsigned)(R * g.lda + C) * 2u; voffB[i] = (unsigned)(Rb * g.ldb + C) * 2u; }
    const size_t kstep = (size_t)(BK * 2);
    const size_t hstepA = (size_t)HALF * g.lda * 2, hstepB = (size_t)HALF * g.ldb * 2;
    const size_t tstepA = 2 * hstepA, tstepB = 2 * hstepB;
    const unsigned ldsw = (unsigned)wid * 1024u;
    const int aoff = lds_byte(wr * 64 + fr, fq * 8), boff = lds_byte(wc * 32 + fr, fq * 8);
#define PG8_SA(b, h) (((b) * 2 + (h)) * HTB)
#define PG8_SB(b, h) ((4 + (b) * 2 + (h)) * HTB)
#define PG8_STAGE(bufoff, gbase, voff) do { _Pragma("unroll") for (int _i = 0; _i < 2; ++_i) \
        __builtin_amdgcn_global_load_lds((const unsigned*)((const char*)(gbase) + (voff)[_i]), (PG8_LAS unsigned*)(lds + (bufoff) + ldsw + _i * 8192), 16, 0, 0); } while (0)
#define PG8_LDA(dst, b, h) do { _Pragma("unroll") for (int m = 0; m < 4; ++m) _Pragma("unroll") for (int k = 0; k < 2; ++k) dst[m][k] = *(const PG8_LAS bf16x8*)(lds + PG8_SA(b, h) + aoff + m * 2048 + k * 1024); } while (0)
#define PG8_LDB(dst, b, h) do { _Pragma("unroll") for (int n = 0; n < 2; ++n) _Pragma("unroll") for (int k = 0; k < 2; ++k) dst[n][k] = *(const PG8_LAS bf16x8*)(lds + PG8_SB(b, h) + boff + n * 2048 + k * 1024); } while (0)
#define PG8_MMA(ai, bj, At, Bt) do { __builtin_amdgcn_s_setprio(1); _Pragma("unroll") for (int m = 0; m < 4; ++m) _Pragma("unroll") for (int n = 0; n < 2; ++n) _Pragma("unroll") for (int k = 0; k < 2; ++k) \
        acc[ai][bj][m][n] = __builtin_amdgcn_mfma_f32_16x16x32_bf16(Bt[n][k], At[m][k], acc[ai][bj][m][n], 0, 0, 0); __builtin_amdgcn_s_setprio(0); } while (0)
#define PG8_WAIT_V(n) asm volatile("s_waitcnt vmcnt(" #n ")" ::: "memory")
#define PG8_WAIT_L(n) asm volatile("s_waitcnt lgkmcnt(" #n ")" ::: "memory")
#define PG8_BAR __builtin_amdgcn_s_barrier()
#define PG8_SCHED __builtin_amdgcn_sched_barrier(0)
    Unit cur, nxt; int ui = 0;
    if (!S.next(0, cur)) return;
    f32x4 acc[2][2][4][2];
#pragma unroll
    for (int a = 0; a < 2; ++a)
#pragma unroll
        for (int b = 0; b < 2; ++b)
#pragma unroll
            for (int m = 0; m < 4; ++m)
#pragma unroll
                for (int n = 0; n < 2; ++n) acc[a][b][m][n] = (f32x4){0.f, 0.f, 0.f, 0.f};
    bf16x8 At[4][2], B0[2][2], B1[2][2];
    const char* cA = (const char*)((Epi::DUAL && cur.part) ? g.A2 : g.A) + (size_t)cur.pm * tstepA; const char* cB = (const char*)((Epi::DUAL && cur.part) ? g.Bt2 : g.Bt) + (size_t)cur.pn * tstepB;
    S.a_ready(cur);
    if constexpr (SP2) {
        PG8_STAGE(PG8_SB(0, 0), cB, voffB); PG8_STAGE(PG8_SB(0, 1), cB + hstepB, voffB); PG8_STAGE(PG8_SA(0, 0), cA, voffA); PG8_STAGE(PG8_SA(0, 1), cA + hstepA, voffA);
        if (wr == 1) PG8_BAR;
        PG8_WAIT_V(2); PG8_BAR;
        PG8_STAGE(PG8_SB(1, 0), cB + kstep, voffB); PG8_STAGE(PG8_SA(1, 0), cA + kstep, voffA); PG8_STAGE(PG8_SB(1, 1), cB + hstepB + kstep, voffB);
        PG8_WAIT_V(6); PG8_BAR;
    } else {
        PG8_STAGE(PG8_SB(0, 0), cB, voffB); PG8_STAGE(PG8_SA(0, 0), cA, voffA); PG8_STAGE(PG8_SB(0, 1), cB + hstepB, voffB); PG8_STAGE(PG8_SA(0, 1), cA + hstepA, voffA);
        if (wr == 1) PG8_BAR;
        PG8_WAIT_V(4); PG8_BAR;
        PG8_STAGE(PG8_SB(1, 0), cB + kstep, voffB); PG8_STAGE(PG8_SA(1, 0), cA + kstep, voffA); PG8_STAGE(PG8_SB(1, 1), cB + hstepB + kstep, voffB);
        PG8_WAIT_V(6); PG8_BAR;
    }
    for (;;) {
        const bool has_next = S.next(ui + 1, nxt);
        const char* nA = has_next ? (const char*)((Epi::DUAL && nxt.part) ? g.A2 : g.A) + (size_t)nxt.pm * tstepA : cA; const char* nB = has_next ? (const char*)((Epi::DUAL && nxt.part) ? g.Bt2 : g.Bt) + (size_t)nxt.pn * tstepB : cB;
        for (int t = 0; t < nt; t += 2) {
            const bool last = (t == nt - 2);
            const char* a1 = cA + (size_t)(t + 1) * kstep;
            const char* a2 = last ? nA : cA + (size_t)(t + 2) * kstep; const char* b2 = last ? nB : cB + (size_t)(t + 2) * kstep;
            const char* a3 = a2 + kstep; const char* b3 = b2 + kstep;
            if (last && has_next) S.a_ready(nxt);
            if constexpr (SP2) {
            PG8_LDB(B0, 0, 0); PG8_LDB(B1, 0, 1); PG8_SCHED; PG8_LDA(At, 0, 0); PG8_STAGE(PG8_SA(1, 1), a1 + hstepA, voffA);
            PG8_WAIT_V(8); PG8_WAIT_L(0); PG8_BAR; PG8_MMA(0, 0, At, B0); PG8_MMA(0, 1, At, B1); PG8_BAR; PG8_SCHED;
            PG8_LDA(At, 0, 1); PG8_STAGE(PG8_SB(0, 0), b2, voffB); PG8_STAGE(PG8_SB(0, 1), b2 + hstepB, voffB); PG8_STAGE(PG8_SA(0, 0), a2, voffA);
            PG8_WAIT_V(8); PG8_WAIT_L(0); PG8_BAR; PG8_MMA(1, 0, At, B0); PG8_MMA(1, 1, At, B1); PG8_BAR; PG8_SCHED;
            PG8_LDB(B0, 1, 0); PG8_LDB(B1, 1, 1); PG8_SCHED; PG8_LDA(At, 1, 0); PG8_STAGE(PG8_SA(0, 1), a2 + hstepA, voffA);
            PG8_WAIT_V(8); PG8_WAIT_L(0); PG8_BAR; PG8_MMA(0, 0, At, B0); PG8_MMA(0, 1, At, B1); PG8_BAR; PG8_SCHED;
            PG8_LDA(At, 1, 1); PG8_STAGE(PG8_SB(1, 0), b3, voffB); PG8_STAGE(PG8_SB(1, 1), b3 + hstepB, voffB); PG8_STAGE(PG8_SA(1, 0), a3, voffA);
            PG8_WAIT_V(8); PG8_WAIT_L(0); PG8_BAR; PG8_MMA(1, 0, At, B0); PG8_MMA(1, 1, At, B1); PG8_BAR; PG8_SCHED;
            } else {
            PG8_LDB(B0, 0, 0); PG8_SCHED; PG8_LDA(At, 0, 0); PG8_STAGE(PG8_SA(1, 1), a1 + hstepA, voffA);
            PG8_WAIT_L(8); PG8_BAR; PG8_WAIT_L(0); PG8_MMA(0, 0, At, B0); PG8_BAR; PG8_SCHED;
            PG8_LDB(B1, 0, 1); PG8_STAGE(PG8_SB(0, 0), b2, voffB);
            PG8_BAR; PG8_WAIT_L(0); PG8_MMA(0, 1, At, B1); PG8_BAR;
            PG8_LDA(At, 0, 1); PG8_STAGE(PG8_SA(0, 0), a2, voffA);
            PG8_BAR; PG8_WAIT_L(0); PG8_MMA(1, 0, At, B0); PG8_BAR; PG8_SCHED;
            PG8_STAGE(PG8_SB(0, 1), b2 + hstepB, voffB);
            PG8_WAIT_V(6); PG8_BAR; PG8_MMA(1, 1, At, B1); PG8_BAR;
            PG8_LDB(B0, 1, 0); PG8_SCHED; PG8_LDA(At, 1, 0); PG8_STAGE(PG8_SA(0, 1), a2 + hstepA, voffA);
            PG8_WAIT_L(8); PG8_BAR; PG8_WAIT_L(0); PG8_MMA(0, 0, At, B0); PG8_BAR; PG8_SCHED;
            PG8_LDB(B1, 1, 1); PG8_STAGE(PG8_SB(1, 0), b3, voffB);
            PG8_BAR; PG8_WAIT_L(0); PG8_MMA(0, 1, At, B1); PG8_BAR;
            PG8_LDA(At, 1, 1); PG8_STAGE(PG8_SA(1, 0), a3, voffA);
            PG8_BAR; PG8_WAIT_L(0); PG8_MMA(1, 0, At, B0); PG8_BAR; PG8_SCHED;
            PG8_STAGE(PG8_SB(1, 1), b3 + hstepB, voffB);
            PG8_WAIT_V(6); PG8_BAR; PG8_MMA(1, 1, At, B1); PG8_BAR;
            }
        }
        if constexpr (ALIGN_EPI) { if (wr == 0) PG8_BAR; }
        bool keep_acc_ = false;
        if constexpr (Epi::DUAL) { if (cur.part == 0) { E.mid(acc, cur, wr, wc, fr, fq); keep_acc_ = true; } else { E(acc, cur, wr, wc, fr, fq); } S.done(cur); }
        else if constexpr (!Epi::AFTER_DRAIN) { E(acc, cur, wr, wc, fr, fq); S.done(cur); }
        if (!has_next) break;
        if (!keep_acc_)
#pragma unroll
        for (int a = 0; a < 2; ++a)
#pragma unroll
            for (int b = 0; b < 2; ++b)
#pragma unroll
                for (int m = 0; m < 4; ++m)
#pragma unroll
                    for (int n = 0; n < 2; ++n) acc[a][b][m][n] = (f32x4){0.f, 0.f, 0.f, 0.f};
        cur = nxt; cA = nA; cB = nB; ++ui;
        if constexpr (ALIGN_EPI) { if (wr == 1) PG8_BAR; }
    }
    PG8_WAIT_V(0);
    if constexpr (!ALIGN_EPI) { if (wr == 0) PG8_BAR; }
    PG8_BAR;
    if constexpr (Epi::AFTER_DRAIN) { E.fused(acc, cur, wr, wc, fr, fq, lds, wid, lane); S.done(cur); }
#undef PG8_SA
#undef PG8_SB
#undef PG8_STAGE
#undef PG8_LDA
#undef PG8_LDB
#undef PG8_MMA
#undef PG8_WAIT_V
#undef PG8_WAIT_L
#undef PG8_BAR
#undef PG8_SCHED
}
}
namespace pg8 {
typedef unsigned u32x2 __attribute__((ext_vector_type(2)));
__device__ __forceinline__ float bf_lo(unsigned w) { return __builtin_bit_cast(float, w << 16); }
__device__ __forceinline__ float bf_hi(unsigned w) { return __builtin_bit_cast(float, w & 0xffff0000u); }
__device__ __forceinline__ float sigmoidf_fast(float x) { return __builtin_amdgcn_rcpf(1.0f + __builtin_amdgcn_exp2f(-1.4426950408889634f * x)); }
template <int MODE> struct EpiB {
    static constexpr bool DUAL = false; static constexpr bool PERM = true, AFTER_DRAIN = false;
    bf16_t* O; int ldc; const float* bias; int bias_skip_tile, bias_skip; const bf16_t* gate; int ldg;
    __device__ __forceinline__ void operator()(const f32x4 (&acc)[2][2][4][2], const Unit& u, int wr, int wc, int fr, int fq) const {
        const int row0 = u.pm * BM + wr * 64 + fr; const int col0 = u.pn * BM + wc * 32 + 8 * fq;
        f32x4 bv[2][2];
        if (MODE == 0) { const int bcol0 = col0 + (u.pn >= bias_skip_tile ? bias_skip : 0);
#pragma unroll
            for (int bj = 0; bj < 2; ++bj)
#pragma unroll
                for (int n = 0; n < 2; ++n) bv[bj][n] = *(const f32x4*)(bias + bcol0 + bj * HALF + 4 * n); }
#pragma unroll
        for (int ai = 0; ai < 2; ++ai)
#pragma unroll
            for (int m = 0; m < 4; ++m) { const int row = row0 + ai * HALF + m * 16; bf16_t* rowp = O + (size_t)row * ldc + col0;
                float rb = 0.f; if (MODE == 1) rb = bias[row];
#pragma unroll
                for (int bj = 0; bj < 2; ++bj) { f32x4 v0 = acc[ai][bj][m][0], v1 = acc[ai][bj][m][1];
                    if (MODE == 0) { v0 = v0 + bv[bj][0]; v1 = v1 + bv[bj][1]; }
                    if (MODE == 1) { v0 = v0 + rb; v1 = v1 + rb; }
                    if (MODE == 2 || MODE == 3) { const u32x4 gw = *(const u32x4*)(gate + (size_t)row * ldg + col0 + bj * HALF);
                        v0[0] *= sigmoidf_fast(bf_lo(gw.x)); v0[1] *= sigmoidf_fast(bf_hi(gw.x)); v0[2] *= sigmoidf_fast(bf_lo(gw.y)); v0[3] *= sigmoidf_fast(bf_hi(gw.y));
                        v1[0] *= sigmoidf_fast(bf_lo(gw.z)); v1[1] *= sigmoidf_fast(bf_hi(gw.z)); v1[2] *= sigmoidf_fast(bf_lo(gw.w)); v1[3] *= sigmoidf_fast(bf_hi(gw.w)); }
                    if (MODE == 3) { const u32x4 pw = *(const u32x4*)(rowp + bj * HALF);
                        v0[0] += bf_lo(pw.x); v0[1] += bf_hi(pw.x); v0[2] += bf_lo(pw.y); v0[3] += bf_hi(pw.y);
                        v1[0] += bf_lo(pw.z); v1[1] += bf_hi(pw.z); v1[2] += bf_lo(pw.w); v1[3] += bf_hi(pw.w); }
                    u32x4 w; w.x = cvt_pk_bf16(v0[0], v0[1]); w.y = cvt_pk_bf16(v0[2], v0[3]); w.z = cvt_pk_bf16(v1[0], v1[1]); w.w = cvt_pk_bf16(v1[2], v1[3]);
                    *(u32x4*)(rowp + bj * HALF) = w; } }
    }
};
template <bool ACCUM> struct EpiGate {
    static constexpr bool DUAL = false; static constexpr bool PERM = true, AFTER_DRAIN = false;
    bf16_t* O; int ldc; const bf16_t* gate; int ldg;
    __device__ __forceinline__ void operator()(const f32x4 (&acc)[2][2][4][2], const Unit& u, int wr, int wc, int fr, int fq) const {
        const int row0 = u.pm * BM + wr * 64 + fr; const int col0 = u.pn * BM + wc * 32 + 8 * fq;
        u32x4 gw[3][2], pw[3][2];
#define EG_LOAD(gg) do { const int rw_ = row0 + ((gg) >> 2) * HALF + ((gg) & 3) * 16; \
            _Pragma("unroll") for (int bj = 0; bj < 2; ++bj) { gw[(gg) % 3][bj] = *(const u32x4*)(gate + (size_t)rw_ * ldg + col0 + bj * HALF); if (ACCUM) pw[(gg) % 3][bj] = *(const u32x4*)(O + (size_t)rw_ * ldc + col0 + bj * HALF); } } while (0)
        EG_LOAD(0); EG_LOAD(1);
#pragma unroll
        for (int g = 0; g < 8; ++g) { const int ai = g >> 2, m = g & 3; const int row = row0 + ai * HALF + m * 16; bf16_t* rowp = O + (size_t)row * ldc + col0;
            if (g + 2 < 8) EG_LOAD(g + 2);
#pragma unroll
            for (int bj = 0; bj < 2; ++bj) { f32x4 v0 = acc[ai][bj][m][0], v1 = acc[ai][bj][m][1]; const u32x4 q = gw[g % 3][bj];
                v0[0] *= sigmoidf_fast(bf_lo(q.x)); v0[1] *= sigmoidf_fast(bf_hi(q.x)); v0[2] *= sigmoidf_fast(bf_lo(q.y)); v0[3] *= sigmoidf_fast(bf_hi(q.y));
                v1[0] *= sigmoidf_fast(bf_lo(q.z)); v1[1] *= sigmoidf_fast(bf_hi(q.z)); v1[2] *= sigmoidf_fast(bf_lo(q.w)); v1[3] *= sigmoidf_fast(bf_hi(q.w));
                if (ACCUM) { const u32x4 p = pw[g % 3][bj];
                    v0[0] += bf_lo(p.x); v0[1] += bf_hi(p.x); v0[2] += bf_lo(p.y); v0[3] += bf_hi(p.y); v1[0] += bf_lo(p.z); v1[1] += bf_hi(p.z); v1[2] += bf_lo(p.w); v1[3] += bf_hi(p.w); }
                u32x4 w; w.x = cvt_pk_bf16(v0[0], v0[1]); w.y = cvt_pk_bf16(v0[2], v0[3]); w.z = cvt_pk_bf16(v1[0], v1[1]); w.w = cvt_pk_bf16(v1[2], v1[3]);
                *(u32x4*)(rowp + bj * HALF) = w; } }
#undef EG_LOAD
    }
};
struct EpiGateDual {
    static constexpr bool DUAL = true; static constexpr bool PERM = true, AFTER_DRAIN = false;
    bf16_t* O; int ldc; const bf16_t* ga; const bf16_t* gc; int ldg;
    static __device__ __forceinline__ float em(float x) { return __builtin_amdgcn_exp2f(-1.4426950408889634f * x); }
    __device__ __forceinline__ void mid(f32x4 (&acc)[2][2][4][2], const Unit& u, int wr, int wc, int fr, int fq) const {
        const int row0 = u.pm * BM + wr * 64 + fr; const int col0 = u.pn * BM + wc * 32 + 8 * fq;
        u32x4 qa[3][2], qc[3][2];
#define EGD_LOAD(gg) do { const int rw_ = row0 + ((gg) >> 2) * HALF + ((gg) & 3) * 16; \
            _Pragma("unroll") for (int bj = 0; bj < 2; ++bj) { qa[(gg) % 3][bj] = *(const u32x4*)(ga + (size_t)rw_ * ldg + col0 + bj * HALF); qc[(gg) % 3][bj] = *(const u32x4*)(gc + (size_t)rw_ * ldg + col0 + bj * HALF); } } while (0)
        EGD_LOAD(0); EGD_LOAD(1);
#pragma unroll
        for (int g = 0; g < 8; ++g) { const int ai = g >> 2, m = g & 3;
            if (g + 2 < 8) EGD_LOAD(g + 2);
#pragma unroll
            for (int bj = 0; bj < 2; ++bj) { const u32x4 a = qa[g % 3][bj], c = qc[g % 3][bj];
#define EGD_R(av, cv) ((1.0f + em(cv)) * __builtin_amdgcn_rcpf(1.0f + em(av)))
                acc[ai][bj][m][0][0] *= EGD_R(bf_lo(a.x), bf_lo(c.x)); acc[ai][bj][m][0][1] *= EGD_R(bf_hi(a.x), bf_hi(c.x)); acc[ai][bj][m][0][2] *= EGD_R(bf_lo(a.y), bf_lo(c.y)); acc[ai][bj][m][0][3] *= EGD_R(bf_hi(a.y), bf_hi(c.y));
                acc[ai][bj][m][1][0] *= EGD_R(bf_lo(a.z), bf_lo(c.z)); acc[ai][bj][m][1][1] *= EGD_R(bf_hi(a.z), bf_hi(c.z)); acc[ai][bj][m][1][2] *= EGD_R(bf_lo(a.w), bf_lo(c.w)); acc[ai][bj][m][1][3] *= EGD_R(bf_hi(a.w), bf_hi(c.w));
#undef EGD_R
            } }
#undef EGD_LOAD
    }
    __device__ __forceinline__ void operator()(const f32x4 (&acc)[2][2][4][2], const Unit& u, int wr, int wc, int fr, int fq) const {
        const int row0 = u.pm * BM + wr * 64 + fr; const int col0 = u.pn * BM + wc * 32 + 8 * fq;
        u32x4 qc[3][2];
#define EGD_LOAD(gg) do { const int rw_ = row0 + ((gg) >> 2) * HALF + ((gg) & 3) * 16; \
            _Pragma("unroll") for (int bj = 0; bj < 2; ++bj) qc[(gg) % 3][bj] = *(const u32x4*)(gc + (size_t)rw_ * ldg + col0 + bj * HALF); } while (0)
        EGD_LOAD(0); EGD_LOAD(1);
#pragma unroll
        for (int g = 0; g < 8; ++g) { const int ai = g >> 2, m = g & 3; const int row = row0 + ai * HALF + m * 16; bf16_t* rowp = O + (size_t)row * ldc + col0;
            if (g + 2 < 8) EGD_LOAD(g + 2);
#pragma unroll
            for (int bj = 0; bj < 2; ++bj) { f32x4 v0 = acc[ai][bj][m][0], v1 = acc[ai][bj][m][1]; const u32x4 q = qc[g % 3][bj];
                v0[0] *= sigmoidf_fast(bf_lo(q.x)); v0[1] *= sigmoidf_fast(bf_hi(q.x)); v0[2] *= sigmoidf_fast(bf_lo(q.y)); v0[3] *= sigmoidf_fast(bf_hi(q.y));
                v1[0] *= sigmoidf_fast(bf_lo(q.z)); v1[1] *= sigmoidf_fast(bf_hi(q.z)); v1[2] *= sigmoidf_fast(bf_lo(q.w)); v1[3] *= sigmoidf_fast(bf_hi(q.w));
                u32x4 w; w.x = cvt_pk_bf16(v0[0], v0[1]); w.y = cvt_pk_bf16(v0[2], v0[3]); w.z = cvt_pk_bf16(v1[0], v1[1]); w.w = cvt_pk_bf16(v1[2], v1[3]);
                *(u32x4*)(rowp + bj * HALF) = w; } }
#undef EGD_LOAD
    }
};
struct PairedOrder {
    StaticOrder so;
    __host__ __device__ void init(int M, int N, int G_, int c_) { so.init(M, N, G_, c_); }
    __host__ __device__ bool next(int i, Unit& u) const { const bool ok = so.next(i >> 1, u); u.part = i & 1; return ok; }
    __device__ __forceinline__ void a_ready(const Unit&) const {}
    __device__ __forceinline__ void done(const Unit&) const {}
};
struct EpiRes {
    static constexpr bool DUAL = false; static constexpr bool PERM = false, AFTER_DRAIN = false;
    const float* base; float* out; int ldc; const float* bias; float alpha;
    __device__ __forceinline__ void operator()(const f32x4 (&acc)[2][2][4][2], const Unit& u, int wr, int wc, int fr, int fq) const {
        const int col0 = u.pn * BM + wc * 32 + 4 * fq;
        f32x4 bv[2][2];
#pragma unroll
        for (int bj = 0; bj < 2; ++bj)
#pragma unroll
            for (int n = 0; n < 2; ++n) bv[bj][n] = *(const f32x4*)(bias + col0 + bj * HALF + n * 16);
#pragma unroll
        for (int ai = 0; ai < 2; ++ai)
#pragma unroll
            for (int m = 0; m < 4; ++m) { const size_t off = (size_t)(u.pm * BM + ai * HALF + wr * 64 + m * 16 + fr) * ldc + col0;
#pragma unroll
                for (int bj = 0; bj < 2; ++bj)
#pragma unroll
                    for (int n = 0; n < 2; ++n) { const f32x4 bs = *(const f32x4*)(base + off + bj * HALF + n * 16);
                        *(f32x4*)(out + off + bj * HALF + n * 16) = bs * alpha + acc[ai][bj][m][n] + bv[bj][n]; } }
    }
};

__device__ __forceinline__ void stats_mr(const f32x2 s, float& mu, float& r) { mu = s.x * (1.0f / 1024.0f); const float var = s.y * (1.0f / 1024.0f) - mu * mu; r = __builtin_amdgcn_rsqf(var + 1e-5f); }
struct EpiLN {
    static constexpr bool DUAL = false; static constexpr bool PERM = true, AFTER_DRAIN = false;
    bf16_t* O; int ldc; const float* cs; const float* bc; int skip_tile, skip; const float* stats;
    __device__ __forceinline__ void operator()(const f32x4 (&acc)[2][2][4][2], const Unit& u, int wr, int wc, int fr, int fq) const {
        const int row0 = u.pm * BM + wr * 64 + fr; const int col0 = u.pn * BM + wc * 32 + 8 * fq; const int bcol0 = col0 + (u.pn >= skip_tile ? skip : 0);
        f32x2 sv[2][4];
#pragma unroll
        for (int ai = 0; ai < 2; ++ai)
#pragma unroll
            for (int m = 0; m < 4; ++m) sv[ai][m] = *(const f32x2*)(stats + 2 * (size_t)(row0 + ai * HALF + m * 16));
        f32x4 cv[2][2], bv[2][2];
#pragma unroll
        for (int bj = 0; bj < 2; ++bj)
#pragma unroll
            for (int n = 0; n < 2; ++n) { cv[bj][n] = *(const f32x4*)(cs + bcol0 + bj * HALF + 4 * n); bv[bj][n] = *(const f32x4*)(bc + bcol0 + bj * HALF + 4 * n); }
#pragma unroll
        for (int ai = 0; ai < 2; ++ai)
#pragma unroll
            for (int m = 0; m < 4; ++m) { const int row = row0 + ai * HALF + m * 16; bf16_t* rowp = O + (size_t)row * ldc + col0;
                float mu, r; stats_mr(sv[ai][m], mu, r);
#pragma unroll
                for (int bj = 0; bj < 2; ++bj) { const f32x4 v0 = (acc[ai][bj][m][0] - cv[bj][0] * mu) * r + bv[bj][0], v1 = (acc[ai][bj][m][1] - cv[bj][1] * mu) * r + bv[bj][1];
                    u32x4 w; w.x = cvt_pk_bf16(v0[0], v0[1]); w.y = cvt_pk_bf16(v0[2], v0[3]); w.z = cvt_pk_bf16(v1[0], v1[1]); w.w = cvt_pk_bf16(v1[2], v1[3]);
                    *(u32x4*)(rowp + bj * HALF) = w; } }
    }
};
struct EpiLNT {
    static constexpr bool DUAL = false; static constexpr bool PERM = true, AFTER_DRAIN = false;
    bf16_t* O; int ldc; const float* cs; const float* bc; const float* stats;
    __device__ __forceinline__ void operator()(const f32x4 (&acc)[2][2][4][2], const Unit& u, int wr, int wc, int fr, int fq) const {
        const int row0 = u.pm * BM + wr * 64 + fr; const int col0 = u.pn * BM + wc * 32 + 8 * fq;
        f32x4 sq[2][4]; float cr[2][4], br[2][4];
#pragma unroll
        for (int bj = 0; bj < 2; ++bj)
#pragma unroll
            for (int q = 0; q < 4; ++q) sq[bj][q] = *(const f32x4*)(stats + 2 * (size_t)(col0 + bj * HALF) + 4 * q);
#pragma unroll
        for (int ai = 0; ai < 2; ++ai)
#pragma unroll
            for (int m = 0; m < 4; ++m) { cr[ai][m] = cs[row0 + ai * HALF + m * 16]; br[ai][m] = bc[row0 + ai * HALF + m * 16]; }
        float mu[2][8], r[2][8];
#pragma unroll
        for (int bj = 0; bj < 2; ++bj)
#pragma unroll
            for (int q = 0; q < 4; ++q) { stats_mr((f32x2){sq[bj][q][0], sq[bj][q][1]}, mu[bj][2 * q], r[bj][2 * q]); stats_mr((f32x2){sq[bj][q][2], sq[bj][q][3]}, mu[bj][2 * q + 1], r[bj][2 * q + 1]); }
#pragma unroll
        for (int ai = 0; ai < 2; ++ai)
#pragma unroll
            for (int m = 0; m < 4; ++m) { const int row = row0 + ai * HALF + m * 16; bf16_t* rowp = O + (size_t)row * ldc + col0; const float c = cr[ai][m], b = br[ai][m];
#pragma unroll
                for (int bj = 0; bj < 2; ++bj) { float v[8];
#pragma unroll
                    for (int e = 0; e < 8; ++e) v[e] = (acc[ai][bj][m][e >> 2][e & 3] - c * mu[bj][e]) * r[bj][e] + b;
                    u32x4 w; w.x = cvt_pk_bf16(v[0], v[1]); w.y = cvt_pk_bf16(v[2], v[3]); w.z = cvt_pk_bf16(v[4], v[5]); w.w = cvt_pk_bf16(v[6], v[7]);
                    *(u32x4*)(rowp + bj * HALF) = w; } }
    }
};
struct EpiRes2 {
    static constexpr bool DUAL = false; static constexpr bool PERM = true, AFTER_DRAIN = false;
    const float* base; float* out; bf16_t* zb; int ldc; const float* bias; const float* bstats; const float* bg; const float* bb; float* ostats;
    __device__ __forceinline__ void operator()(const f32x4 (&acc)[2][2][4][2], const Unit& u, int wr, int wc, int fr, int fq) const {
        constexpr float alpha = 1.41421356237309515f;
        const int urow = u.pm * BM + wr * 64, ucol = u.pn * BM + wc * 32;
        const size_t ubase = (size_t)urow * ldc + ucol;
        const char* bp = (const char*)(base + ubase); char* op = (char*)(out + ubase); char* zp = (char*)(zb + ubase);
        const char* sp = (const char*)(bstats + 2 * (size_t)urow); float* osp = ostats + 2 * (size_t)urow;
        const unsigned l4 = (unsigned)(fr * ldc + 8 * fq) * 4u, l2 = (unsigned)(fr * ldc + 8 * fq) * 2u, ls = (unsigned)fr * 8u;
        const int col0 = ucol + 8 * fq;
        f32x4 gv[2][2], cv[2][2];
#pragma unroll
        for (int bj = 0; bj < 2; ++bj)
#pragma unroll
            for (int n = 0; n < 2; ++n) { gv[bj][n] = *(const f32x4*)(bg + col0 + bj * HALF + 4 * n) * alpha;
                cv[bj][n] = *(const f32x4*)(bb + col0 + bj * HALF + 4 * n) * alpha + *(const f32x4*)(bias + col0 + bj * HALF + 4 * n); }
        f32x2 sv_c = *(const f32x2*)(sp + ls);
        f32x4 p0 = *(const f32x4*)(bp + l4), p1 = *(const f32x4*)(bp + l4 + 16);
#pragma unroll
        for (int g = 0; g < 8; ++g) { const int ai = g >> 2, m = g & 3; const int rr = ai * HALF + m * 16, rn = ((g + 1) >> 2) * HALF + ((g + 1) & 3) * 16;
            f32x2 sv_n = sv_c; if (g + 1 < 8) sv_n = *(const f32x2*)(sp + (size_t)rn * 8 + ls);
            float mu, r; stats_mr(sv_c, mu, r); float s1 = 0.f, s2 = 0.f;
#pragma unroll
            for (int bj = 0; bj < 2; ++bj) { const size_t ro = (size_t)rr * ldc + bj * HALF;
                f32x4 q0 = p0, q1 = p1;
                if (bj == 0) { q0 = *(const f32x4*)(bp + (ro + HALF) * 4 + l4); q1 = *(const f32x4*)(bp + (ro + HALF) * 4 + l4 + 16); }
                else if (g + 1 < 8) { q0 = *(const f32x4*)(bp + (size_t)rn * ldc * 4 + l4); q1 = *(const f32x4*)(bp + (size_t)rn * ldc * 4 + l4 + 16); }
                const f32x4 z0 = gv[bj][0] * ((p0 - mu) * r) + acc[ai][bj][m][0] + cv[bj][0], z1 = gv[bj][1] * ((p1 - mu) * r) + acc[ai][bj][m][1] + cv[bj][1];
                *(f32x4*)(op + ro * 4 + l4) = z0; *(f32x4*)(op + ro * 4 + l4 + 16) = z1;
                s1 += ((z0[0] + z0[1]) + (z0[2] + z0[3])) + ((z1[0] + z1[1]) + (z1[2] + z1[3]));
                s2 += ((z0[0] * z0[0] + z0[1] * z0[1]) + (z0[2] * z0[2] + z0[3] * z0[3])) + ((z1[0] * z1[0] + z1[1] * z1[1]) + (z1[2] * z1[2] + z1[3] * z1[3]));
                if (zb) { u32x4 w; w.x = cvt_pk_bf16(z0[0], z0[1]); w.y = cvt_pk_bf16(z0[2], z0[3]); w.z = cvt_pk_bf16(z1[0], z1[1]); w.w = cvt_pk_bf16(z1[2], z1[3]); *(u32x4*)(zp + ro * 2 + l2) = w; }
                p0 = q0; p1 = q1; }
            s1 += __shfl_xor(s1, 16); s2 += __shfl_xor(s2, 16); s1 += __shfl_xor(s1, 32); s2 += __shfl_xor(s2, 32);
            if (fq == 0) { atomicAdd(osp + 2 * (rr + fr), s1); atomicAdd(osp + 2 * (rr + fr) + 1, s2); }
            sv_c = sv_n; }
    }
};
}
#define LAS __attribute__((address_space(3)))
typedef unsigned short bf16;
typedef unsigned v4u __attribute__((ext_vector_type(4)));
typedef unsigned v2u __attribute__((ext_vector_type(2)));
typedef float f32x4 __attribute__((ext_vector_type(4)));
typedef short bf16x8 __attribute__((ext_vector_type(8)));
constexpr int NWAVES = 8, NTHR = 512;
constexpr int DM = 1024, MC = 32768, NCHUNK = 3, NLAYER = 2;
constexpr int PW = 4608;
constexpr int AW = 512, DFF = 2816, NUP = 5632, PROJ_W = 5120;
constexpr int C_Q = 0, C_K = 512, C_U = 1024, C_GB = 1536, C_GC = 2048, C_GA = 2560, C_GCC = 3584;
constexpr float ALPHA = 1.41421356237309515f, LN_EPS = 1e-5f, LOG2E = 1.4426950408889634f;
constexpr size_t OFF_WIN = 0, OFF_WV = OFF_WIN + (size_t)PW * DM, OFF_WA = OFF_WV + (size_t)AW * DM, OFF_WC = OFF_WA + (size_t)DM * AW,
                 OFF_WO = OFF_WC + (size_t)DM * AW, OFF_WUP = OFF_WO + (size_t)DM * DM, OFF_WDN = OFF_WUP + (size_t)NUP * DM, W_LAYER = (size_t)16 << 20;
static_assert(OFF_WDN + (size_t)DM * DFF <= W_LAYER, "weights per layer");
constexpr size_t MiB = (size_t)1 << 20;
constexpr size_t WS_W = 0, WS_XB = 64 * MiB, WS_PROJ = 128 * MiB, WS_VT = 416 * MiB, WS_YA = 448 * MiB, WS_YC = 480 * MiB, WS_MG = 512 * MiB,
                 WS_H = 128 * MiB, WS_G = 576 * MiB, WS_ZERO = 752 * MiB, ZERO_BYTES = 4 * MiB, WS_ST = WS_ZERO, WS_CS = WS_ZERO + 3 * MiB, WS_BAR = WS_ZERO + 3 * MiB + 512 * 1024, WS_ID = 756 * MiB, WS_END = 757 * MiB;
constexpr int CS_IN = 0, BC_IN = 5120, CS_UP = 10240, BC_UP = 10240 + 5632, CS_LAYER = 10240 + 2 * 5632;
static_assert((size_t)NCHUNK * NLAYER * 2 * MC * 2 * 4 <= 3 * MiB && (size_t)NLAYER * CS_LAYER * 4 <= MiB, "zeroed region");
static_assert(WS_PROJ + (size_t)MC * PW * 2 <= WS_VT && WS_H + (size_t)MC * NUP * 2 <= WS_YC && WS_G + (size_t)MC * DFF * 2 <= WS_ZERO, "ws map");
constexpr int LDS_BYTES = 147456;

__device__ __forceinline__ unsigned f2bf(float f) { unsigned u = __builtin_bit_cast(unsigned, f); return (u + 0x7fffu + ((u >> 16) & 1u)) >> 16; }
__device__ __forceinline__ unsigned pk2(float lo, float hi) { return f2bf(lo) | (f2bf(hi) << 16); }
__device__ __forceinline__ float wave_sum(float v) {
#pragma unroll
    for (int o = 1; o < 64; o <<= 1) v += __shfl_xor(v, o);
    return v;
}
using pg8::bf_lo; using pg8::bf_hi; using pg8::cvt_pk_bf16;

__device__ __forceinline__ void transpose_item(const float* W, int K, int N, bf16* WT, int rowadj, LAS float* scr, int item, int lane,
                                               const float* gk, const float* bk, const float* bias, float* cs, float* bc) {
    const int nblk = N / 32, kb = item / nblk, nb = item % nblk, k0 = 64 * kb, n0 = 32 * nb;
    float pcs = 0.f, pbc = 0.f;
    float wl_[32];
#pragma unroll
    for (int i = 0; i < 32; ++i) wl_[i] = __builtin_nontemporal_load(W + (size_t)(k0 + 2 * i + (lane >> 5)) * N + n0 + (lane & 31));
#pragma unroll
    for (int i = 0; i < 32; ++i) { const int kk = 2 * i + (lane >> 5); const float w = wl_[i];
        float wg = w; if (gk) wg = w * gk[k0 + kk]; scr[kk * 33 + (lane & 31)] = wg;
        if (cs) { pcs += __builtin_bit_cast(float, f2bf(wg) << 16); if (bk) pbc += bk[k0 + kk] * w; } }
    if (cs) { pcs += __shfl_xor(pcs, 32); pbc += __shfl_xor(pbc, 32); if (kb == 0) pbc += bias[n0 + (lane & 31)];
        if (lane < 32) { atomicAdd(cs + n0 + lane, pcs); atomicAdd(bc + n0 + lane, pbc); } }
    asm volatile("s_waitcnt lgkmcnt(0)" ::: "memory");
    const int c = lane & 7;
#pragma unroll
    for (int j = 0; j < 4; ++j) { const int n = (lane >> 3) + 8 * j; const LAS float* s = scr + (8 * c) * 33 + n;
        v4u o; o.x = pk2(s[0 * 33], s[1 * 33]); o.y = pk2(s[2 * 33], s[3 * 33]); o.z = pk2(s[4 * 33], s[5 * 33]); o.w = pk2(s[6 * 33], s[7 * 33]);
        *(v4u*)(WT + (size_t)(n0 + n + rowadj) * K + k0 + 8 * c) = o; }
    asm volatile("s_waitcnt lgkmcnt(0)" ::: "memory");
}

__device__ __forceinline__ const float* idptr(const unsigned char* ws, int off) { asm volatile("" : "+s"(off)); return (const float*)(ws + WS_ID) + off; }
struct Args { const float* in[21]; float* out; unsigned char* ws; int ph_lo, ph_hi; };
__device__ __forceinline__ const float* ldin(const Args& a, int i) { asm volatile("" : "+s"(i)); return a.in[i]; }

__device__ __forceinline__ void prologue_weights(const Args& a, LAS unsigned char* lds, int gw, int NGW, int wave, int lane) {
    LAS float* scr = (LAS float*)(lds + wave * 16384);
    constexpr int I_IN = (DM / 64) * (PROJ_W / 32), I_BR = (AW / 64) * (DM / 32), I_O = (DM / 64) * (DM / 32), I_UP = (DM / 64) * (NUP / 32), I_DN = (DFF / 64) * (DM / 32);
    constexpr int PER_LAYER = I_IN + 2 * I_BR + I_O + I_UP + I_DN;
    for (int it = gw; it < NLAYER * PER_LAYER; it += NGW) {
        const int l = it / PER_LAYER; int r = it % PER_LAYER;
        bf16* wl = (bf16*)(a.ws + WS_W) + (size_t)l * W_LAYER;
        float* csl = (float*)(a.ws + WS_CS) + (size_t)l * CS_LAYER;
        if (r < I_IN) { const int nb = r % (PROJ_W / 32), n0 = nb * 32; const float* W = ldin(a, 2) + (size_t)l * DM * PROJ_W;
            const float* gk = l > 0 ? ldin(a, 19) + (size_t)(l - 1) * DM : nullptr; const float* bk = l > 0 ? ldin(a, 20) + (size_t)(l - 1) * DM : nullptr;
            bf16* dst = (n0 >= 1024 && n0 < 1536) ? wl + OFF_WV : wl + OFF_WIN; const int adj = n0 < 1024 ? 0 : (n0 < 1536 ? -1024 : -512);
            transpose_item(W, DM, PROJ_W, dst, adj, scr, r, lane, gk, bk, ldin(a, 3) + (size_t)l * PROJ_W, csl + CS_IN, csl + BC_IN);
            continue; } r -= I_IN;
        if (r < I_BR) { transpose_item(ldin(a, 7) + (size_t)l * AW * DM, AW, DM, wl + OFF_WA, 0, scr, r, lane, nullptr, nullptr, nullptr, nullptr, nullptr); continue; } r -= I_BR;
        if (r < I_BR) { transpose_item(ldin(a, 8) + (size_t)l * AW * DM, AW, DM, wl + OFF_WC, 0, scr, r, lane, nullptr, nullptr, nullptr, nullptr, nullptr); continue; } r -= I_BR;
        if (r < I_O) { transpose_item(ldin(a, 9) + (size_t)l * DM * DM, DM, DM, wl + OFF_WO, 0, scr, r, lane, nullptr, nullptr, nullptr, nullptr, nullptr); continue; } r -= I_O;
        if (r < I_UP) { transpose_item(ldin(a, 13) + (size_t)l * DM * NUP, DM, NUP, wl + OFF_WUP, 0, scr, r, lane, ldin(a, 11) + (size_t)l * DM, ldin(a, 12) + (size_t)l * DM,
                                       ldin(a, 14) + (size_t)l * NUP, csl + CS_UP, csl + BC_UP); continue; } r -= I_UP;
        transpose_item(ldin(a, 17) + (size_t)l * DFF * DM, DFF, DM, wl + OFF_WDN, 0, scr, r, lane, nullptr, nullptr, nullptr, nullptr, nullptr);
    }
}
__device__ __forceinline__ void convert_rows(const float* x, bf16* xb, int nrows, int vcu, int NGW) {
    int t_ = threadIdx.x; asm volatile("" : "+v"(t_)); const int lane = t_ & 63, gw = vcu * NWAVES + __builtin_amdgcn_readfirstlane(t_ >> 6);
    for (int m = gw * 4; m < nrows; m += NGW * 4) {
        f32x4 v[4][4];
#pragma unroll
        for (int q = 0; q < 4; ++q) { const f32x4* xr = (const f32x4*)(x + (size_t)(m + q) * DM) + lane;
#pragma unroll
            for (int j = 0; j < 4; ++j) v[q][j] = __builtin_nontemporal_load(xr + 64 * j); }
#pragma unroll
        for (int q = 0; q < 4; ++q) { v2u* o = (v2u*)(xb + (size_t)(m + q) * DM) + lane;
#pragma unroll
            for (int j = 0; j < 4; ++j) { v2u w; w.x = cvt_pk_bf16(v[q][j][0], v[q][j][1]); w.y = cvt_pk_bf16(v[q][j][2], v[q][j][3]); o[64 * j] = w; } }
    }
}
__device__ __forceinline__ void ln_rows(float* z, bf16* xb, const float* g, const float* b, int nrows, int vcu, int NGW, bool write_xb) {
    int t_ = threadIdx.x; asm volatile("" : "+v"(t_)); const int lane = t_ & 63, gw = vcu * NWAVES + __builtin_amdgcn_readfirstlane(t_ >> 6);
    f32x4 gv[4], bv[4];
#pragma unroll
    for (int j = 0; j < 4; ++j) { gv[j] = ((const f32x4*)g)[64 * j + lane]; bv[j] = ((const f32x4*)b)[64 * j + lane]; }
    for (int m = gw * 2; m < nrows; m += NGW * 2) {
        f32x4 v[2][4];
#pragma unroll
        for (int q = 0; q < 2; ++q) { const f32x4* xr = (const f32x4*)(z + (size_t)(m + q) * DM) + lane;
#pragma unroll
            for (int j = 0; j < 4; ++j) v[q][j] = xr[64 * j]; }
#pragma unroll
        for (int q = 0; q < 2; ++q) { f32x4* xr = (f32x4*)(z + (size_t)(m + q) * DM) + lane; v2u* o = (v2u*)(xb + (size_t)(m + q) * DM) + lane;
            float s = 0.f;
#pragma unroll
            for (int j = 0; j < 4; ++j) s += (v[q][j][0] + v[q][j][1]) + (v[q][j][2] + v[q][j][3]);
            const float mean = wave_sum(s) * (1.f / DM); float s2 = 0.f;
#pragma unroll
            for (int j = 0; j < 4; ++j) { v[q][j] = v[q][j] - mean; s2 += (v[q][j][0] * v[q][j][0] + v[q][j][1] * v[q][j][1]) + (v[q][j][2] * v[q][j][2] + v[q][j][3] * v[q][j][3]); }
            const float rstd = 1.f / sqrtf(wave_sum(s2) * (1.f / DM) + LN_EPS);
#pragma unroll
            for (int j = 0; j < 4; ++j) { const f32x4 y = v[q][j] * rstd * gv[j] + bv[j]; xr[64 * j] = y;
                if (write_xb) { v2u w; w.x = cvt_pk_bf16(y[0], y[1]); w.y = cvt_pk_bf16(y[2], y[3]); o[64 * j] = w; } } }
    }
}
__device__ __forceinline__ void unpack8(const v4u w, float (&f)[8]) {
    f[0] = bf_lo(w.x); f[1] = bf_hi(w.x); f[2] = bf_lo(w.y); f[3] = bf_hi(w.y); f[4] = bf_lo(w.z); f[5] = bf_hi(w.z); f[6] = bf_lo(w.w); f[7] = bf_hi(w.w);
}
__device__ __forceinline__ void convbranch_phase(const bf16* proj, bf16* yc, const float* cw, const float* cb, int T, int vcu, int NT) {
    int t_ = threadIdx.x; asm volatile("" : "+v"(t_)); const int gtid = vcu * NTHR + t_;
    constexpr int NG = AW / 8, L = 16, R = MC / L;
    for (int item = gtid; item < NG * R; item += NT) {
        const int run = item / NG, ch = (item - run * NG) * 8, t0 = run * L;
        float w0[8], w1[8], w2[8], bb[8];
#pragma unroll
        for (int e = 0; e < 8; e += 4) { *(f32x4*)(w0 + e) = *(const f32x4*)(cw + ch + e); *(f32x4*)(w1 + e) = *(const f32x4*)(cw + AW + ch + e);
            *(f32x4*)(w2 + e) = *(const f32x4*)(cw + 2 * AW + ch + e); *(f32x4*)(bb + e) = *(const f32x4*)(cb + ch + e); }
        const bf16* p = proj + (size_t)t0 * PW + ch;
        float pp[8], pc[8], fu[8], fc[8];
        { unpack8(*(const v4u*)(p + C_U), fu); unpack8(*(const v4u*)(p + C_GC), fc);
#pragma unroll
          for (int e = 0; e < 8; ++e) pc[e] = fu[e] * fc[e]; }
        if (t0 > 0) { unpack8(*(const v4u*)(p - PW + C_U), fu); unpack8(*(const v4u*)(p - PW + C_GC), fc);
#pragma unroll
          for (int e = 0; e < 8; ++e) pp[e] = fu[e] * fc[e]; }
        else {
#pragma unroll
          for (int e = 0; e < 8; ++e) pp[e] = 0.f; }
        for (int t = t0; t < t0 + L; t += 8) {
            const v4u z4 = (v4u){0u, 0u, 0u, 0u}; v4u un[8], cn[8], gq[8];
#pragma unroll
            for (int q = 0; q < 8; ++q) { un[q] = z4; cn[q] = z4; gq[q] = *(const v4u*)(p + (size_t)q * PW + C_GB);
                if (t + q + 1 < MC) { un[q] = *(const v4u*)(p + (size_t)(q + 1) * PW + C_U); cn[q] = *(const v4u*)(p + (size_t)(q + 1) * PW + C_GC); } }
#pragma unroll
            for (int q = 0; q < 8; ++q) { const int tpos = (t + q) & (T - 1);
                float fg[8], pn[8], r[8]; unpack8(gq[q], fg); unpack8(un[q], fu); unpack8(cn[q], fc);
                const float mp = tpos == 0 ? 0.f : 1.f, mn = tpos == T - 1 ? 0.f : 1.f;
#pragma unroll
                for (int e = 0; e < 8; ++e) { pn[e] = fu[e] * fc[e]; r[e] = fg[e] * (w0[e] * (pp[e] * mp) + w1[e] * pc[e] + w2[e] * (pn[e] * mn) + bb[e]); pp[e] = pc[e]; pc[e] = pn[e]; }
                v4u o; o.x = cvt_pk_bf16(r[0], r[1]); o.y = cvt_pk_bf16(r[2], r[3]); o.z = cvt_pk_bf16(r[4], r[5]); o.w = cvt_pk_bf16(r[6], r[7]);
                *(v4u*)(yc + (size_t)(t + q) * AW + ch) = o; }
            p += 8 * (size_t)PW;
        }
    }
}
__device__ __forceinline__ float gelu_tanh(float x) {
    const float u = x * (0.7978845608028654f + 0.035677408136300125f * x * x);
    return x * __builtin_amdgcn_rcpf(1.0f + __builtin_amdgcn_exp2f(-2.0f * LOG2E * u));
}
__device__ __forceinline__ void ffnconv_phase(const bf16* h, bf16* gout, const float* cw, const float* cb, int T, int vcu, int NT) {
    int t_ = threadIdx.x; asm volatile("" : "+v"(t_)); const int gtid = vcu * NTHR + t_;
    constexpr int NG = DFF / 8, L = 96, R = (MC + L - 1) / L, RS = 8;
    static_assert(L % RS == 0 && MC % RS == 0, "rows are walked RS at a time");
    for (int item = gtid; item < NG * R; item += NT) {
        const int run = item / NG, ch = (item - run * NG) * 8, t0 = run * L, t1 = (t0 + L < MC) ? t0 + L : MC;
        float wg0[8], wg1[8], wg2[8], bg[8], wv0[8], wv1[8], wv2[8], bv[8];
#pragma unroll
        for (int e = 0; e < 8; e += 4) {
            *(f32x4*)(wg0 + e) = *(const f32x4*)(cw + ch + e); *(f32x4*)(wg1 + e) = *(const f32x4*)(cw + NUP + ch + e); *(f32x4*)(wg2 + e) = *(const f32x4*)(cw + 2 * NUP + ch + e); *(f32x4*)(bg + e) = *(const f32x4*)(cb + ch + e);
            *(f32x4*)(wv0 + e) = *(const f32x4*)(cw + DFF + ch + e); *(f32x4*)(wv1 + e) = *(const f32x4*)(cw + NUP + DFF + ch + e); *(f32x4*)(wv2 + e) = *(const f32x4*)(cw + 2 * NUP + DFF + ch + e); *(f32x4*)(bv + e) = *(const f32x4*)(cb + DFF + ch + e); }
        const bf16* p = h + (size_t)t0 * NUP + ch;
        const v4u z4 = (v4u){0u, 0u, 0u, 0u};
        v4u gp_ = z4, vp_ = z4, gc_ = *(const v4u*)(p), vc_ = *(const v4u*)(p + DFF);
        if (t0 > 0) { gp_ = *(const v4u*)(p - NUP); vp_ = *(const v4u*)(p - NUP + DFF); }
        for (int t = t0; t < t1; t += RS) {
            v4u gn_[RS], vn_[RS];
#pragma unroll
            for (int q = 0; q < RS; ++q) { gn_[q] = z4; vn_[q] = z4; if (t + q + 1 < MC) { gn_[q] = __builtin_nontemporal_load((const v4u*)(p + (size_t)(q + 1) * NUP)); vn_[q] = __builtin_nontemporal_load((const v4u*)(p + (size_t)(q + 1) * NUP + DFF)); } }
#pragma unroll
            for (int q = 0; q < RS; ++q) {
                const int tpos = (t + q) & (T - 1);
                const float mp = tpos == 0 ? 0.f : 1.f, mn = tpos == T - 1 ? 0.f : 1.f;
                float a0[8], a1[8], a2[8], b0[8], b1[8], b2[8], r[8];
                unpack8(gp_, a0); unpack8(gc_, a1); unpack8(gn_[q], a2); unpack8(vp_, b0); unpack8(vc_, b1); unpack8(vn_[q], b2);
#pragma unroll
                for (int e = 0; e < 8; ++e) { const float hg = wg0[e] * (a0[e] * mp) + wg1[e] * a1[e] + wg2[e] * (a2[e] * mn) + bg[e];
                    const float hv = wv0[e] * (b0[e] * mp) + wv1[e] * b1[e] + wv2[e] * (b2[e] * mn) + bv[e]; r[e] = gelu_tanh(hg) * hv; }
                v4u o; o.x = cvt_pk_bf16(r[0], r[1]); o.y = cvt_pk_bf16(r[2], r[3]); o.z = cvt_pk_bf16(r[4], r[5]); o.w = cvt_pk_bf16(r[6], r[7]);
                *(v4u*)(gout + (size_t)(t + q) * DFF + ch) = o;
                gp_ = gc_; gc_ = gn_[q]; vp_ = vc_; vc_ = vn_[q]; }
            p += RS * (size_t)NUP;
        }
    }
}
__device__ __forceinline__ void attn_phase(const bf16* __restrict__ proj, const bf16* __restrict__ vt, bf16* __restrict__ ya, const float* __restrict__ rpb, int T, int vcu, int G, LAS unsigned char* lds) {
    int t_ = threadIdx.x; asm volatile("" : "+v"(t_)); const int lane = t_ & 63, wave = __builtin_amdgcn_readfirstlane(t_ >> 6);
    LAS float* tbl = (LAS float*)lds;
    for (int idx = wave * 64 + lane; idx < 8 * 15 * 31; idx += NTHR) tbl[idx] = rpb[idx] * LOG2E;
    __syncthreads();
    const int rows = T >> 6, nrgp = rows >> 4;
    const int n = lane & 15, q4 = lane >> 4, c = wave & 3, q0 = c * 16, cs = (c == 0) ? 0 : (c == 1) ? 8 : (c == 2) ? 24 : 32;
    const float SC = 0.125f * LOG2E;
    const unsigned qlane = (unsigned)(n * PW + 8 * q4) * 2u, klane = (unsigned)((8 * (n >> 2) + (n & 3)) * PW + 8 * q4) * 2u, vlane = (unsigned)(n * MC + 8 * q4) * 2u, olane = (unsigned)(n * AW + 4 * q4) * 2u;
    unsigned dpack0 = 0u, dpack1 = 0u, vmask = 0u;
    { const int qj = q0 + n; int js = qj - 8; js = js < 0 ? 0 : js; js = js > 48 ? 48 : js;
#pragma unroll
      for (int hf = 0; hf < 2; ++hf)
#pragma unroll
          for (int j = 0; j < 4; ++j) { const int kj = cs + 8 * q4 + 4 * hf + j; const bool v = (kj >= js) && (kj < js + 16); int dc = kj - qj + 15; dc = dc < 0 ? 0 : dc; dc = dc > 30 ? 30 : dc;
              if (hf == 0) dpack0 |= (unsigned)dc << (8 * j); else dpack1 |= (unsigned)dc << (8 * j); vmask |= (v ? 1u : 0u) << (hf * 4 + j); } }
    asm volatile("" : "+v"(dpack0), "+v"(dpack1), "+v"(vmask));
    for (int wt = vcu; wt < 256; wt += G) {
        const int rgp = wt % nrgp, h = (wt / nrgp) & 7, s = wt / (nrgp * 8), rg = rgp * 2 + (wave >> 2);
        const LAS float* tbh = tbl + h * 15 * 31;
        for (int pass = 0; pass < 2; ++pass) {
            const int i0 = rg * 8 + pass * 4;
            int rsj[4];
#pragma unroll
            for (int j = 0; j < 4; ++j) { int r_ = i0 + j - 4; r_ = r_ < 0 ? 0 : r_; r_ = r_ > rows - 8 ? rows - 8 : r_; rsj[j] = r_; }
            const int ka0 = rsj[0], ka1 = rsj[3] + 7;
            const size_t tok0 = (size_t)s * T;
            bf16x8 qf[4][2];
#pragma unroll
            for (int j = 0; j < 4; ++j) { const char* qb = (const char*)(proj + (tok0 + (size_t)(i0 + j) * 64 + q0) * PW + C_Q + h * 64); qf[j][0] = *(const bf16x8*)(qb + qlane); qf[j][1] = *(const bf16x8*)(qb + qlane + 64); }
            const char* kb = (const char*)(proj + (tok0 + cs) * PW + C_K + h * 64);
            const char* vb = (const char*)(vt + (size_t)(h * 64) * MC + tok0 + cs);
            f32x4 o[4][4]; float mrun[4], lrun[4];
#pragma unroll
            for (int j = 0; j < 4; ++j) { mrun[j] = -INFINITY; lrun[j] = 0.f;
#pragma unroll
                for (int dt = 0; dt < 4; ++dt) o[j][dt] = (f32x4){0.f, 0.f, 0.f, 0.f}; }
            bf16x8 kf[2][2]; v4u vf[4];
            { const char* kp = kb + (size_t)ka0 * 64 * PW * 2;
#pragma unroll
              for (int hf = 0; hf < 2; ++hf) { kf[hf][0] = *(const bf16x8*)(kp + (size_t)(4 * hf) * PW * 2 + klane); kf[hf][1] = *(const bf16x8*)(kp + (size_t)(4 * hf) * PW * 2 + klane + 64); }
            }
            for (int ka = ka0; ka <= ka1; ++ka) {
                bf16x8 kn[2][2];
#pragma unroll
                for (int hf = 0; hf < 2; ++hf) { kn[hf][0] = kf[hf][0]; kn[hf][1] = kf[hf][1]; }
                { const char* vp = vb + (size_t)ka * 64 * 2;
#pragma unroll
                  for (int dt = 0; dt < 4; ++dt) vf[dt] = *(const v4u*)(vp + (size_t)(16 * dt) * MC * 2 + vlane); }
                if (ka < ka1) { const char* kp = kb + (size_t)(ka + 1) * 64 * PW * 2;
#pragma unroll
                    for (int hf = 0; hf < 2; ++hf) { kn[hf][0] = *(const bf16x8*)(kp + (size_t)(4 * hf) * PW * 2 + klane); kn[hf][1] = *(const bf16x8*)(kp + (size_t)(4 * hf) * PW * 2 + klane + 64); } }
#pragma unroll
                for (int j = 0; j < 4; ++j) { const int kr = ka - rsj[j];
                    if (kr >= 0 && kr < 8) {
                        f32x4 st[2];
#pragma unroll
                        for (int hf = 0; hf < 2; ++hf) { const f32x4 t = __builtin_amdgcn_mfma_f32_16x16x32_bf16(kf[hf][0], qf[j][0], (f32x4){0.f, 0.f, 0.f, 0.f}, 0, 0, 0);
                            st[hf] = __builtin_amdgcn_mfma_f32_16x16x32_bf16(kf[hf][1], qf[j][1], t, 0, 0, 0); }
                        const LAS float* tb = tbh + (ka - i0 - j + 7) * 31;
                        float mloc = -INFINITY;
#pragma unroll
                        for (int hf = 0; hf < 2; ++hf)
#pragma unroll
                            for (int e = 0; e < 4; ++e) { const unsigned dc = ((hf == 0 ? dpack0 : dpack1) >> (8 * e)) & 0xffu; const float b = tb[dc];
                                const float v = ((vmask >> (hf * 4 + e)) & 1u) ? st[hf][e] * SC + b : -INFINITY; st[hf][e] = v; mloc = fmaxf(mloc, v); }
                        mloc = fmaxf(mloc, __shfl_xor(mloc, 16)); mloc = fmaxf(mloc, __shfl_xor(mloc, 32));
                        const float mnew = fmaxf(mrun[j], mloc), alpha = __builtin_amdgcn_exp2f(mrun[j] - mnew); mrun[j] = mnew;
                        float p[8], psum = 0.f;
#pragma unroll
                        for (int hf = 0; hf < 2; ++hf)
#pragma unroll
                            for (int e = 0; e < 4; ++e) { p[hf * 4 + e] = __builtin_amdgcn_exp2f(st[hf][e] - mnew); psum += p[hf * 4 + e]; }
                        lrun[j] = lrun[j] * alpha + psum;
                        v4u w; w.x = cvt_pk_bf16(p[0], p[1]); w.y = cvt_pk_bf16(p[2], p[3]); w.z = cvt_pk_bf16(p[4], p[5]); w.w = cvt_pk_bf16(p[6], p[7]);
                        const bf16x8 pk = __builtin_bit_cast(bf16x8, w);
#pragma unroll
                        for (int dt = 0; dt < 4; ++dt) o[j][dt] = __builtin_amdgcn_mfma_f32_16x16x32_bf16(__builtin_bit_cast(bf16x8, vf[dt]), pk, o[j][dt] * alpha, 0, 0, 0);
                    } }
#pragma unroll
                for (int hf = 0; hf < 2; ++hf) { kf[hf][0] = kn[hf][0]; kf[hf][1] = kn[hf][1]; }
            }
#pragma unroll
            for (int j = 0; j < 4; ++j) { float l = lrun[j]; l += __shfl_xor(l, 16); l += __shfl_xor(l, 32); const float inv = 1.0f / l;
                char* ob = (char*)(ya + (tok0 + (size_t)(i0 + j) * 64 + q0) * AW + h * 64);
#pragma unroll
                for (int dt = 0; dt < 4; ++dt) { v2u w; w.x = cvt_pk_bf16(o[j][dt][0] * inv, o[j][dt][1] * inv); w.y = cvt_pk_bf16(o[j][dt][2] * inv, o[j][dt][3] * inv); *(v2u*)(ob + olane + 32 * dt) = w; } }
        }
    }
}
#define XB_TMO      128
#define XB_XCNT(j)  (256  + 64 * (j))
#define XB_XSUB(j)  (1280 + 64 * (j))
#define XB_XGEN(j)  (2304 + 64 * (j))
#define XB_TOP      3328
#define XB_TOPGEN   3392
#define XCD_BAR_WORDS 3456
#define XB_SPIN_CAP (1u << 18)

__device__ __forceinline__ unsigned xb_ld(unsigned* p)              { return __hip_atomic_load(p, __ATOMIC_RELAXED, __HIP_MEMORY_SCOPE_AGENT); }
__device__ __forceinline__ unsigned xb_add(unsigned* p, unsigned v) { return __hip_atomic_fetch_add(p, v, __ATOMIC_RELAXED, __HIP_MEMORY_SCOPE_AGENT); }
__device__ __forceinline__ unsigned xb_xcc_id() { return (unsigned)__builtin_amdgcn_s_getreg((3 << 11) | 20) & 0xFu; }
#define XB_SPIN(cond, bar) do { unsigned _sp = 0; while (cond) { __builtin_amdgcn_s_sleep(1); \
    if ((++_sp & 255u) == 0u) { if (xb_ld(&(bar)[XB_TMO])) break; if (_sp > XB_SPIN_CAP) { atomicAdd(&(bar)[XB_TMO], 1u); break; } } } } while (0)

struct XcdBarrier {
    unsigned* bar; unsigned x;
    volatile LAS unsigned* st;
};

__device__ __forceinline__ XcdBarrier xcd_barrier_post(unsigned* bar, volatile LAS unsigned* st) {
    XcdBarrier b; b.bar = bar; b.x = xb_xcc_id(); b.st = st;
    if (threadIdx.x == 0) (void)xb_add(&bar[XB_XCNT(b.x)], 1u);
    return b;
}
__device__ __forceinline__ void xcd_barrier_complete(unsigned* bar, unsigned x, unsigned& nloc, unsigned& nx) {
    const unsigned G = gridDim.x * gridDim.y * gridDim.z;
    unsigned sum, cnt, mine, sp = 0u;
    for (;;) {
        sum = 0u; cnt = 0u; mine = 0u;
#pragma unroll
        for (unsigned j = 0; j < 16; ++j) { const unsigned c = xb_ld(&bar[XB_XCNT(j)]); sum += c; cnt += (c > 0u) ? 1u : 0u; mine = (j == x) ? c : mine; }
        if (sum == G) break;
        __builtin_amdgcn_s_sleep(1);
        if ((++sp & 255u) == 0u) { if (xb_ld(&bar[XB_TMO])) break; if (sp > XB_SPIN_CAP) { atomicAdd(&bar[XB_TMO], 1u); break; } }
    }
    nloc = mine > 0u ? mine : 1u; nx = cnt > 0u ? cnt : 1u;
}

__device__ __forceinline__ void xcd_barrier(const XcdBarrier& b) {
    asm volatile("s_waitcnt vmcnt(0)" ::: "memory");
    __syncthreads();
    if (threadIdx.x == 0) {
        unsigned* bar = b.bar;
        __builtin_amdgcn_s_waitcnt(0);
        unsigned nloc = b.st[0], nx = b.st[1];
        if (nloc == 0u) { xcd_barrier_complete(bar, b.x, nloc, nx); b.st[0] = nloc; b.st[1] = nx; }
        const unsigned old = xb_add(&bar[XB_XSUB(b.x)], 1u);
        const unsigned gen = old / nloc;
        if (old + 1u == (gen + 1u) * nloc) {
            __builtin_amdgcn_fence(__ATOMIC_RELEASE, "agent");
            asm volatile("s_waitcnt vmcnt(0)" ::: "memory");
            const unsigned og = xb_add(&bar[XB_TOP], 1u);
            const unsigned tg = og / nx;
            if (og + 1u == (tg + 1u) * nx) xb_add(&bar[XB_TOPGEN], 1u);
            else XB_SPIN(xb_ld(&bar[XB_TOPGEN]) == tg, bar);
            __builtin_amdgcn_fence(__ATOMIC_ACQUIRE, "agent");
            xb_add(&bar[XB_XGEN(b.x)], 1u);
            asm volatile("s_waitcnt vmcnt(0)" ::: "memory");
        } else {
            XB_SPIN(xb_ld(&bar[XB_XGEN(b.x)]) == gen, bar);
            __builtin_amdgcn_fence(__ATOMIC_ACQUIRE, "agent");
            asm volatile("s_waitcnt vmcnt(0)" ::: "memory");
        }
    }
    __syncthreads();
}
#define IN(i) ldin(a, i)
__global__ void __launch_bounds__(NTHR, 2) mega_fwd(Args a) {
    extern __shared__ __attribute__((aligned(16))) unsigned char lds_raw[];
    LAS unsigned char* lds = (LAS unsigned char*)lds_raw;
    cg::grid_group grid = cg::this_grid();
    const int tid = threadIdx.x, lane0 = tid & 63, wave0 = __builtin_amdgcn_readfirstlane(tid >> 6);
    const int G = gridDim.x, bx = blockIdx.x;
    const int vcu = (G % 8 == 0) ? (bx % 8) * (G / 8) + bx / 8 : bx;
    const int gw0 = vcu * NWAVES + wave0, NGW = G * NWAVES, gtid0 = vcu * NTHR + tid, NT = G * NTHR;
    unsigned char* ws = a.ws;
    bf16* XB = (bf16*)(ws + WS_XB); bf16* PROJ = (bf16*)(ws + WS_PROJ); bf16* VT = (bf16*)(ws + WS_VT); bf16* YA = (bf16*)(ws + WS_YA); bf16* YC = (bf16*)(ws + WS_YC);
    bf16* MG = (bf16*)(ws + WS_MG); bf16* HB = (bf16*)(ws + WS_H); bf16* GB = (bf16*)(ws + WS_G);
    int ph = 0;
    volatile LAS unsigned* bst = (volatile LAS unsigned*)(lds + 131072 + 64);
    if (tid < 2) bst[tid] = 0u;
    __syncthreads();
    XcdBarrier xbar = xcd_barrier_post((unsigned*)(ws + WS_BAR), bst);
#define SEAM() do { xcd_barrier(xbar); } while (0)
#define IDST idptr(ws, 0)
#define ONES idptr(ws, 2 * MC)
#define ZEROS idptr(ws, 2 * MC + DM)
#define STATS(ll, sub) ((float*)(ws + WS_ST) + (size_t)((chunk * NLAYER + (ll)) * 2 + (sub)) * MC * 2)

    prologue_weights(a, lds, gw0, NGW, wave0, lane0);
    convert_rows(IN(0), XB, MC, vcu, NGW);
    { float* idp = (float*)(ws + WS_ID);
      for (int i = gtid0; i < MC; i += NT) { idp[2 * i] = 0.f; idp[2 * i + 1] = 1024.0f * (1.0f - 1e-5f); }
      for (int i = gtid0; i < DM; i += NT) { idp[2 * MC + i] = 1.f; idp[2 * MC + DM + i] = 0.f; } }
    grid.sync();

    for (int chunk = 0; chunk < NCHUNK; ++chunk) {
        const float* xin = (chunk == 0) ? IN(0) : IN(1) + (size_t)(chunk - 1) * MC * DM;
        float* outc = a.out + (size_t)chunk * MC * DM;
        const int T = (chunk == 0) ? 8192 : 2048;
        for (int l = 0; l < NLAYER; ++l) {
            const bf16* wl = (const bf16*)(ws + WS_W) + (size_t)l * W_LAYER;
            const float* csl = (const float*)(ws + WS_CS) + (size_t)l * CS_LAYER;
            { pg8::Gemm g{XB, wl + OFF_WIN, MC, PW, DM, DM, DM}; pg8::StaticOrder S; S.init(MC, PW, G, bx);
              pg8::EpiLN E{PROJ, PW, csl + CS_IN, csl + BC_IN, 4, 512, l > 0 ? STATS(l - 1, 1) : IDST};
              pg8::gemm_phase<pg8::EpiLN, pg8::StaticOrder, true, true>(lds, g, S, E); }
            { pg8::Gemm g{wl + OFF_WV, XB, AW, MC, DM, DM, DM}; pg8::StaticOrder S; S.init(AW, MC, G, bx);
              pg8::EpiLNT E{VT, MC, csl + CS_IN + 1024, csl + BC_IN + 1024, l > 0 ? STATS(l - 1, 1) : IDST};
              pg8::gemm_phase<pg8::EpiLNT, pg8::StaticOrder, true, true>(lds, g, S, E); }
            SEAM();
            attn_phase(PROJ, VT, YA, IN(4) + (size_t)l * 8 * 15 * 31, T, vcu, G, lds);
            convbranch_phase(PROJ, YC, IN(5) + (size_t)l * 3 * AW, IN(6) + (size_t)l * AW, T, vcu, NT);
            SEAM();
            { pg8::Gemm g{YA, wl + OFF_WA, MC, DM, AW, AW, AW, YC, wl + OFF_WC}; pg8::PairedOrder S; S.init(MC, DM, G, bx);
              pg8::EpiGateDual E{MG, DM, PROJ + C_GA, PROJ + C_GCC, PW};
              pg8::gemm_phase<pg8::EpiGateDual, pg8::PairedOrder, true, true>(lds, g, S, E); }
            SEAM();
            { pg8::Gemm g{MG, wl + OFF_WO, MC, DM, DM, DM, DM}; pg8::StaticOrder S; S.init(MC, DM, G, bx);
              pg8::EpiRes2 E{(l == 0) ? xin : outc, outc, XB, DM, IN(10) + (size_t)l * DM, l > 0 ? STATS(l - 1, 1) : IDST,
                             l > 0 ? IN(19) + (size_t)(l - 1) * DM : ONES, l > 0 ? IN(20) + (size_t)(l - 1) * DM : ZEROS, STATS(l, 0)};
              pg8::gemm_phase<pg8::EpiRes2, pg8::StaticOrder, true, true>(lds, g, S, E); }
            SEAM();
            { pg8::Gemm g{XB, wl + OFF_WUP, MC, NUP, DM, DM, DM}; pg8::StaticOrder S; S.init(MC, NUP, G, bx);
              pg8::EpiLN E{HB, NUP, csl + CS_UP, csl + BC_UP, 1 << 30, 0, STATS(l, 0)};
              pg8::gemm_phase<pg8::EpiLN, pg8::StaticOrder, true, true>(lds, g, S, E); }
            SEAM();
            ffnconv_phase(HB, GB, IN(15) + (size_t)l * 3 * NUP, IN(16) + (size_t)l * NUP, T, vcu, NT);
            SEAM();
            { pg8::Gemm g{GB, wl + OFF_WDN, MC, DM, DFF, DFF, DFF}; pg8::StaticOrder S; S.init(MC, DM, G, bx);
              pg8::EpiRes2 E{outc, outc, (l + 1 < NLAYER) ? XB : nullptr, DM, IN(18) + (size_t)l * DM, STATS(l, 0), IN(11) + (size_t)l * DM, IN(12) + (size_t)l * DM, STATS(l, 1)};
              pg8::gemm_phase<pg8::EpiRes2, pg8::StaticOrder, true, true>(lds, g, S, E); }
            SEAM();
            if (l + 1 == NLAYER) {
                ln_rows(outc, XB, IN(19) + (size_t)l * DM, IN(20) + (size_t)l * DM, MC, vcu, NGW, false);
                if (chunk + 1 < NCHUNK) { convert_rows(IN(1) + (size_t)chunk * MC * DM, XB, MC, vcu, NGW); SEAM(); }
            }
        }
    }
    (void)ph;
}

extern "C" void kernel_launch(void* const* d_in, const int* in_sizes, int n_in, void* d_out, int out_size, void* d_ws, size_t ws_size, hipStream_t stream) {
    static int grid = 0;
    if (grid == 0) {
        if (n_in != 21 || out_size != NCHUNK * MC * DM || ws_size < WS_END) { fprintf(stderr, "kernel_launch: unexpected shapes: n_in %d out %d ws %zu\n", n_in, out_size, ws_size); grid = -1; return; }
        int dev = 0, cus = 0, per_cu = 0;
        if (hipGetDevice(&dev) != hipSuccess || hipDeviceGetAttribute(&cus, hipDeviceAttributeMultiprocessorCount, dev) != hipSuccess) { grid = -1; return; }
        if (hipFuncSetAttribute((const void*)mega_fwd, hipFuncAttributeMaxDynamicSharedMemorySize, LDS_BYTES) != hipSuccess) { fprintf(stderr, "kernel_launch: hipFuncSetAttribute failed\n"); grid = -1; return; }
        if (hipOccupancyMaxActiveBlocksPerMultiprocessor(&per_cu, (const void*)mega_fwd, NTHR, LDS_BYTES) != hipSuccess || per_cu < 1) { fprintf(stderr, "kernel_launch: occupancy query says %d\n", per_cu); per_cu = 1; }
        (void)hipGetLastError();
        grid = cus;
    }
    if (grid < 0) return;
    if (hipMemsetAsync((char*)d_ws + WS_ZERO, 0, ZERO_BYTES, stream) != hipSuccess) { fprintf(stderr, "kernel_launch: memset failed\n"); return; }
    Args a{};
    for (int i = 0; i < 21; ++i) a.in[i] = (const float*)d_in[i];
    a.out = (float*)d_out; a.ws = (unsigned char*)d_ws; a.ph_lo = 0; a.ph_hi = 0;
    void* args[] = {&a};
    hipError_t e = hipLaunchCooperativeKernel((const void*)mega_fwd, dim3(grid), dim3(NTHR), args, LDS_BYTES, stream);
    if (e != hipSuccess) fprintf(stderr, "kernel_launch: cooperative launch failed: %s (grid %d)\n", hipGetErrorString(e), grid);
}
```

```cpp
#include <hip/hip_runtime.h>
#include <hip/hip_cooperative_groups.h>
#include <cstdio>
#include <cstdint>
namespace cg = cooperative_groups;
namespace pg8 {
#define PG8_LAS __attribute__((address_space(3)))
typedef unsigned short bf16_t;
typedef short bf16x8 __attribute__((ext_vector_type(8)));
typedef float f32x4 __attribute__((ext_vector_type(4)));
typedef unsigned u32x4 __attribute__((ext_vector_type(4)));
constexpr int BM = 256, BK = 64, HALF = 128, HTB = HALF * BK * 2  , STAGE_BYTES = 8 * HTB, NXCD = 8, WGM = 8;

__host__ __device__ __forceinline__ int lds_byte(int r, int c) { const int st = (r >> 4) * 2 + (c >> 5), rr = r & 15, cc = c & 31, ob = rr * 64 + cc * 2; return st * 1024 + (ob ^ (((ob >> 9) & 1) << 5)); }
__host__ __device__ __forceinline__ void stage_rc(int b, int& R, int& C) { const int st = b / 1024, sb = b % 1024, swz = sb ^ (((sb >> 9) & 1) << 5); R = (st >> 1) * 16 + swz / 64; C = (st & 1) * 32 + (swz % 64) / 2; }
__host__ __device__ __forceinline__ int perm32(int rho) { const int n = rho >> 4, i = rho & 15; return 8 * (i >> 2) + 4 * n + (i & 3); }

struct Unit { int pm, pn, part; };
struct Gemm { const bf16_t* A; const bf16_t* Bt; int M, N, K, lda, ldb; const bf16_t* A2; const bf16_t* Bt2; };

struct StaticOrder {
    int nM, nN, nwg, G, c;
    __host__ __device__ void init(int M, int N, int G_, int c_) { nM = M / BM; nN = N / BM; nwg = nM * nN; G = G_; c = c_; }
    __host__ __device__ bool next(int i, Unit& u) const {
        const long L = (long)i * G + c; if (L >= nwg) return false;
        int wgid = (int)L; { const int q = nwg / NXCD, r = nwg % NXCD, xcd = wgid % NXCD, off = wgid / NXCD; wgid = (xcd < r ? xcd * (q + 1) : r * (q + 1) + (xcd - r) * q) + off; }
        const int nig = WGM * nN, gid = wgid / nig, fm = gid * WGM, gsz = (nM - fm) < WGM ? (nM - fm) : WGM;
        u.pm = fm + ((wgid % nig) % gsz); u.pn = (wgid % nig) / gsz; u.part = 0; return true;
    }
    __device__ __forceinline__ void a_ready(const Unit&) const {}
    __device__ __forceinline__ void done(const Unit&) const {}
};

__device__ __forceinline__ unsigned cvt_pk_bf16(float lo, float hi) { unsigned r; asm volatile("v_cvt_pk_bf16_f32 %0, %1, %2" : "=v"(r) : "v"(lo), "v"(hi)); return r; }
typedef float f32x2 __attribute__((ext_vector_type(2)));
template <class Epi, class Sched, bool ALIGN_EPI = false, bool SP2 = false>
__device__ __forceinline__ void gemm_phase(PG8_LAS unsigned char* lds, const Gemm g, const Sched& S, const Epi& E) {
    int tid_ = threadIdx.x; asm volatile("" : "+v"(tid_));
    const int tid = tid_, wid = __builtin_amdgcn_readfirstlane(tid >> 6), lane = tid & 63, wr = wid >> 2, wc = wid & 3, fr = lane & 15, fq = lane >> 4;
    const int K = g.K, nt = K / BK;
    unsigned voffA[2], voffB[2];
#pragma unroll
    for (int i = 0; i < 2; ++i) { int R, C; stage_rc(tid * 16 + i * 8192, R, C); const int Rb = Epi::PERM ? ((R & ~31) + perm32(R & 31)) : R;
        voffA[i] = (unsigned)(R * g.lda + C) * 2u; voffB[i] = (unsigned)(Rb * g.ldb + C) * 2u; }
    const size_t kstep = (size_t)(BK * 2);
    const size_t hstepA = (size_t)HALF * g.lda * 2, hstepB = (size_t)HALF * g.ldb * 2;
    const size_t tstepA = 2 * hstepA, tstepB = 2 * hstepB;
    const unsigned ldsw = (unsigned)wid * 1024u;
    const int aoff = lds_byte(wr * 64 + fr, fq * 8), boff = lds_byte(wc * 32 + fr, fq * 8);
#define PG8_SA(b, h) (((b) * 2 + (h)) * HTB)
#define PG8_SB(b, h) ((4 + (b) * 2 + (h)) * HTB)
#define PG8_STAGE(bufoff, gbase, voff) do { _Pragma("unroll") for (int _i = 0; _i < 2; ++_i) \
        __builtin_amdgcn_global_load_lds((const unsigned*)((const char*)(gbase) + (voff)[_i]), (PG8_LAS unsigned*)(lds + (bufoff) + ldsw + _i * 8192), 16, 0, 0); } while (0)
#define PG8_LDA(dst, b, h) do { _Pragma("unroll") for (int m = 0; m < 4; ++m) _Pragma("unroll") for (int k = 0; k < 2; ++k) dst[m][k] = *(const PG8_LAS bf16x8*)(lds + PG8_SA(b, h) + aoff + m * 2048 + k * 1024); } while (0)
#define PG8_LDB(dst, b, h) do { _Pragma("unroll") for (int n = 0; n < 2; ++n) _Pragma("unroll") for (int k = 0; k < 2; ++k) dst[n][k] = *(const PG8_LAS bf16x8*)(lds + PG8_SB(b, h) + boff + n * 2048 + k * 1024); } while (0)
#define PG8_MMA(ai, bj, At, Bt) do { __builtin_amdgcn_s_setprio(1); _Pragma("unroll") for (int m = 0; m < 4; ++m) _Pragma("unroll") for (int n = 0; n < 2; ++n) _Pragma("unroll") for (int k = 0; k < 2; ++k) \
        acc[ai][bj][m][n] = __builtin_amdgcn_mfma_f32_16x16x32_bf16(Bt[n][k], At[m][k], acc[ai][bj][m][n], 0, 0, 0); __builtin_amdgcn_s_setprio(0); } while (0)
#define PG8_WAIT_V(n) asm volatile("s_waitcnt vmcnt(" #n ")" ::: "memory")
#define PG8_WAIT_L(n) asm volatile("s_waitcnt lgkmcnt(" #n ")" ::: "memory")
#define PG8_BAR __builtin_amdgcn_s_barrier()
#define PG8_SCHED __builtin_amdgcn_sched_barrier(0)
    Unit cur, nxt; int ui = 0;
    if (!S.next(0, cur)) return;
    f32x4 acc[2][2][4][2];
#pragma unroll
    for (int a = 0; a < 2; ++a)
#pragma unroll
        for (int b = 0; b < 2; ++b)
#pragma unroll
            for (int m = 0; m < 4; ++m)
#pragma unroll
                for (int n = 0; n < 2; ++n) acc[a][b][m][n] = (f32x4){0.f, 0.f, 0.f, 0.f};
    bf16x8 At[4][2], B0[2][2], B1[2][2];
    const char* cA = (const char*)((Epi::DUAL && cur.part) ? g.A2 : g.A) + (size_t)cur.pm * tstepA; const char* cB = (const char*)((Epi::DUAL && cur.part) ? g.Bt2 : g.Bt) + (size_t)cur.pn * tstepB;
    S.a_ready(cur);
    if constexpr (SP2) {
        PG8_STAGE(PG8_SB(0, 0), cB, voffB); PG8_STAGE(PG8_SB(0, 1), cB + hstepB, voffB); PG8_STAGE(PG8_SA(0, 0), cA, voffA); PG8_STAGE(PG8_SA(0, 1), cA + hstepA, voffA);
        if (wr == 1) PG8_BAR;
        PG8_WAIT_V(2); PG8_BAR;
        PG8_STAGE(PG8_SB(1, 0), cB + kstep, voffB); PG8_STAGE(PG8_SA(1, 0), cA + kstep, voffA); PG8_STAGE(PG8_SB(1, 1), cB + hstepB + kstep, voffB);
        PG8_WAIT_V(6); PG8_BAR;
    } else {
        PG8_STAGE(PG8_SB(0, 0), cB, voffB); PG8_STAGE(PG8_SA(0, 0), cA, voffA); PG8_STAGE(PG8_SB(0, 1), cB + hstepB, voffB); PG8_STAGE(PG8_SA(0, 1), cA + hstepA, voffA);
        if (wr == 1) PG8_BAR;
        PG8_WAIT_V(4); PG8_BAR;
        PG8_STAGE(PG8_SB(1, 0), cB + kstep, voffB); PG8_STAGE(PG8_SA(1, 0), cA + kstep, voffA); PG8_STAGE(PG8_SB(1, 1), cB + hstepB + kstep, voffB);
        PG8_WAIT_V(6); PG8_BAR;
    }
    for (;;) {
        const bool has_next = S.next(ui + 1, nxt);
        const char* nA = has_next ? (const char*)((Epi::DUAL && nxt.part) ? g.A2 : g.A) + (size_t)nxt.pm * tstepA : cA; const char* nB = has_next ? (const char*)((Epi::DUAL && nxt.part) ? g.Bt2 : g.Bt) + (size_t)nxt.pn * tstepB : cB;
        for (int t = 0; t < nt; t += 2) {
            const bool last = (t == nt - 2);
            const char* a1 = cA + (size_t)(t + 1) * kstep;
            const char* a2 = last ? nA : cA + (size_t)(t + 2) * kstep; const char* b2 = last ? nB : cB + (size_t)(t + 2) * kstep;
            const char* a3 = a2 + kstep; const char* b3 = b2 + kstep;
            if (last && has_next) S.a_ready(nxt);
            if constexpr (SP2) {
            PG8_LDB(B0, 0, 0); PG8_LDB(B1, 0, 1); PG8_SCHED; PG8_LDA(At, 0, 0); PG8_STAGE(PG8_SA(1, 1), a1 + hstepA, voffA);
            PG8_WAIT_V(8); PG8_WAIT_L(0); PG8_BAR; PG8_MMA(0, 0, At, B0); PG8_MMA(0, 1, At, B1); PG8_BAR; PG8_SCHED;
            PG8_LDA(At, 0, 1); PG8_STAGE(PG8_SB(0, 0), b2, voffB); PG8_STAGE(PG8_SB(0, 1), b2 + hstepB, voffB); PG8_STAGE(PG8_SA(0, 0), a2, voffA);
            PG8_WAIT_V(8); PG8_WAIT_L(0); PG8_BAR; PG8_MMA(1, 0, At, B0); PG8_MMA(1, 1, At, B1); PG8_BAR; PG8_SCHED;
            PG8_LDB(B0, 1, 0); PG8_LDB(B1, 1, 1); PG8_SCHED; PG8_LDA(At, 1, 0); PG8_STAGE(PG8_SA(0, 1), a2 + hstepA, voffA);
            PG8_WAIT_V(8); PG8_WAIT_L(0); PG8_BAR; PG8_MMA(0, 0, At, B0); PG8_MMA(0, 1, At, B1); PG8_BAR; PG8_SCHED;
            PG8_LDA(At, 1, 1); PG8_STAGE(PG8_SB(1, 0), b3, voffB); PG8_STAGE(PG8_SB(1, 1), b3 + hstepB, voffB); PG8_STAGE(PG8_SA(1, 0), a3, voffA);
            PG8_WAIT_V(8); PG8_WAIT_L(0); PG8_BAR; PG8_MMA(1, 0, At, B0); PG8_MMA(1, 1, At, B1); PG8_BAR; PG8_SCHED;
            } else {
            PG8_LDB(B0, 0, 0); PG8_SCHED; PG8_LDA(At, 0, 0); PG8_STAGE(PG8_SA(1, 1), a1 + hstepA, voffA);
            PG8_WAIT_L(8); PG8_BAR; PG8_WAIT_L(0); PG8_MMA(0, 0, At, B0); PG8_BAR; PG8_SCHED;
            PG8_LDB(B1, 0, 1); PG8_STAGE(PG8_SB(0, 0), b2, voffB);
            PG8_BAR; PG8_WAIT_L(0); PG8_MMA(0, 1, At, B1); PG8_BAR;
            PG8_LDA(At, 0, 1); PG8_STAGE(PG8_SA(0, 0), a2, voffA);
            PG8_BAR; PG8_WAIT_L(0); PG8_MMA(1, 0, At, B0); PG8_BAR; PG8_SCHED;
            PG8_STAGE(PG8_SB(0, 1), b2 + hstepB, voffB);
            PG8_WAIT_V(6); PG8_BAR; PG8_MMA(1, 1, At, B1); PG8_BAR;
            PG8_LDB(B0, 1, 0); PG8_SCHED; PG8_LDA(At, 1, 0); PG8_STAGE(PG8_SA(0, 1), a2 + hstepA, voffA);
            PG8_WAIT_L(8); PG8_BAR; PG8_WAIT_L(0); PG8_MMA(0, 0, At, B0); PG8_BAR; PG8_SCHED;
            PG8_LDB(B1, 1, 1); PG8_STAGE(PG8_SB(1, 0), b3, voffB);
            PG8_BAR; PG8_WAIT_L(0); PG8_MMA(0, 1, At, B1); PG8_BAR;
            PG8_LDA(At, 1, 1); PG8_STAGE(PG8_SA(1, 0), a3, voffA);
            PG8_BAR; PG8_WAIT_L(0); PG8_MMA(1, 0, At, B0); PG8_BAR; PG8_SCHED;
            PG8_STAGE(PG8_SB(1, 1), b3 + hstepB, voffB);
            PG8_WAIT_V(6); PG8_BAR; PG8_MMA(1, 1, At, B1); PG8_BAR;
            }
        }
        if constexpr (ALIGN_EPI) { if (wr == 0) PG8_BAR; }
        bool keep_acc_ = false;
        if constexpr (Epi::DUAL) { if (cur.part == 0) { E.mid(acc, cur, wr, wc, fr, fq); keep_acc_ = true; } else { E(acc, cur, wr, wc, fr, fq); } S.done(cur); }
        else if constexpr (!Epi::AFTER_DRAIN) { E(acc, cur, wr, wc, fr, fq); S.done(cur); }
        if (!has_next) break;
        if (!keep_acc_)
#pragma unroll
        for (int a = 0; a < 2; ++a)
#pragma unroll
            for (int b = 0; b < 2; ++b)
#pragma unroll
                for (int m = 0; m < 4; ++m)
#pragma unroll
                    for (int n = 0; n < 2; ++n) acc[a][b][m][n] = (f32x4){0.f, 0.f, 0.f, 0.f};
        cur = nxt; cA = nA; cB = nB; ++ui;
        if constexpr (ALIGN_EPI) { if (wr == 1) PG8_BAR; }
    }
    PG8_WAIT_V(0);
    if constexpr (!ALIGN_EPI) { if (wr == 0) PG8_BAR; }
    PG8_BAR;
    if constexpr (Epi::AFTER_DRAIN) { E.fused(acc, cur, wr, wc, fr, fq, lds, wid, lane); S.done(cur); }
#undef PG8_SA
#undef PG8_SB
#undef PG8_STAGE
#undef PG8_LDA
#undef PG8_LDB
#undef PG8_MMA
#undef PG8_WAIT_V
#undef PG8_WAIT_L
#undef PG8_BAR
#undef PG8_SCHED
}
}
namespace pg8 {
typedef unsigned u32x2 __attribute__((ext_vector_type(2)));
__device__ __forceinline__ float bf_lo(unsigned w) { return __builtin_bit_cast(float, w << 16); }
__device__ __forceinline__ float bf_hi(unsigned w) { return __builtin_bit_cast(float, w & 0xffff0000u); }
__device__ __forceinline__ float sigmoidf_fast(float x) { return __builtin_amdgcn_rcpf(1.0f + __builtin_amdgcn_exp2f(-1.4426950408889634f * x)); }
template <int MODE> struct EpiB {
    static constexpr bool DUAL = false; static constexpr bool PERM = true, AFTER_DRAIN = false;
    bf16_t* O; int ldc; const float* bias; int bias_skip_tile, bias_skip; const bf16_t* gate; int ldg;
    __device__ __forceinline__ void operator()(const f32x4 (&acc)[2][2][4][2], const Unit& u, int wr, int wc, int fr, int fq) const {
        const int row0 = u.pm * BM + wr * 64 + fr; const int col0 = u.pn * BM + wc * 32 + 8 * fq;
        f32x4 bv[2][2];
        if (MODE == 0) { const int bcol0 = col0 + (u.pn >= bias_skip_tile ? bias_skip : 0);
#pragma unroll
            for (int bj = 0; bj < 2; ++bj)
#pragma unroll
                for (int n = 0; n < 2; ++n) bv[bj][n] = *(const f32x4*)(bias + bcol0 + bj * HALF + 4 * n); }
#pragma unroll
        for (int ai = 0; ai < 2; ++ai)
#pragma unroll
            for (int m = 0; m < 4; ++m) { const int row = row0 + ai * HALF + m * 16; bf16_t* rowp = O + (size_t)row * ldc + col0;
                float rb = 0.f; if (MODE == 1) rb = bias[row];
#pragma unroll
                for (int bj = 0; bj < 2; ++bj) { f32x4 v0 = acc[ai][bj][m][0], v1 = acc[ai][bj][m][1];
                    if (MODE == 0) { v0 = v0 + bv[bj][0]; v1 = v1 + bv[bj][1]; }
                    if (MODE == 1) { v0 = v0 + rb; v1 = v1 + rb; }
                    if (MODE == 2 || MODE == 3) { const u32x4 gw = *(const u32x4*)(gate + (size_t)row * ldg + col0 + bj * HALF);
                        v0[0] *= sigmoidf_fast(bf_lo(gw.x)); v0[1] *= sigmoidf_fast(bf_hi(gw.x)); v0[2] *= sigmoidf_fast(bf_lo(gw.y)); v0[3] *= sigmoidf_fast(bf_hi(gw.y));
                        v1[0] *= sigmoidf_fast(bf_lo(gw.z)); v1[1] *= sigmoidf_fast(bf_hi(gw.z)); v1[2] *= sigmoidf_fast(bf_lo(gw.w)); v1[3] *= sigmoidf_fast(bf_hi(gw.w)); }
                    if (MODE == 3) { const u32x4 pw = *(const u32x4*)(rowp + bj * HALF);
                        v0[0] += bf_lo(pw.x); v0[1] += bf_hi(pw.x); v0[2] += bf_lo(pw.y); v0[3] += bf_hi(pw.y);
                        v1[0] += bf_lo(pw.z); v1[1] += bf_hi(pw.z); v1[2] += bf_lo(pw.w); v1[3] += bf_hi(pw.w); }
                    u32x4 w; w.x = cvt_pk_bf16(v0[0], v0[1]); w.y = cvt_pk_bf16(v0[2], v0[3]); w.z = cvt_pk_bf16(v1[0], v1[1]); w.w = cvt_pk_bf16(v1[2], v1[3]);
                    *(u32x4*)(rowp + bj * HALF) = w; } }
    }
};
template <bool ACCUM> struct EpiGate {
    static constexpr bool DUAL = false; static constexpr bool PERM = true, AFTER_DRAIN = false;
    bf16_t* O; int ldc; const bf16_t* gate; int ldg;
    __device__ __forceinline__ void operator()(const f32x4 (&acc)[2][2][4][2], const Unit& u, int wr, int wc, int fr, int fq) const {
        const int row0 = u.pm * BM + wr * 64 + fr; const int col0 = u.pn * BM + wc * 32 + 8 * fq;
        u32x4 gw[3][2], pw[3][2];
#define EG_LOAD(gg) do { const int rw_ = row0 + ((gg) >> 2) * HALF + ((gg) & 3) * 16; \
            _Pragma("unroll") for (int bj = 0; bj < 2; ++bj) { gw[(gg) % 3][bj] = *(const u32x4*)(gate + (size_t)rw_ * ldg + col0 + bj * HALF); if (ACCUM) pw[(gg) % 3][bj] = *(const u32x4*)(O + (size_t)rw_ * ldc + col0 + bj * HALF); } } while (0)
        EG_LOAD(0); EG_LOAD(1);
#pragma unroll
        for (int g = 0; g < 8; ++g) { const int ai = g >> 2, m = g & 3; const int row = row0 + ai * HALF + m * 16; bf16_t* rowp = O + (size_t)row * ldc + col0;
            if (g + 2 < 8) EG_LOAD(g + 2);
#pragma unroll
            for (int bj = 0; bj < 2; ++bj) { f32x4 v0 = acc[ai][bj][m][0], v1 = acc[ai][bj][m][1]; const u32x4 q = gw[g % 3][bj];
                v0[0] *= sigmoidf_fast(bf_lo(q.x)); v0[1] *= sigmoidf_fast(bf_hi(q.x)); v0[2] *= sigmoidf_fast(bf_lo(q.y)); v0[3] *= sigmoidf_fast(bf_hi(q.y));
                v1[0] *= sigmoidf_fast(bf_lo(q.z)); v1[1] *= sigmoidf_fast(bf_hi(q.z)); v1[2] *= sigmoidf_fast(bf_lo(q.w)); v1[3] *= sigmoidf_fast(bf_hi(q.w));
                if (ACCUM) { const u32x4 p = pw[g % 3][bj];
                    v0[0] += bf_lo(p.x); v0[1] += bf_hi(p.x); v0[2] += bf_lo(p.y); v0[3] += bf_hi(p.y); v1[0] += bf_lo(p.z); v1[1] += bf_hi(p.z); v1[2] += bf_lo(p.w); v1[3] += bf_hi(p.w); }
                u32x4 w; w.x = cvt_pk_bf16(v0[0], v0[1]); w.y = cvt_pk_bf16(v0[2], v0[3]); w.z = cvt_pk_bf16(v1[0], v1[1]); w.w = cvt_pk_bf16(v1[2], v1[3]);
                *(u32x4*)(rowp + bj * HALF) = w; } }
#undef EG_LOAD
    }
};
struct EpiGateDual {
    static constexpr bool DUAL = true; static constexpr bool PERM = true, AFTER_DRAIN = false;
    bf16_t* O; int ldc; const bf16_t* ga; const bf16_t* gc; int ldg;
    static __device__ __forceinline__ float em(float x) { return __builtin_amdgcn_exp2f(-1.4426950408889634f * x); }
    __device__ __forceinline__ void mid(f32x4 (&acc)[2][2][4][2], const Unit& u, int wr, int wc, int fr, int fq) const {
        const int row0 = u.pm * BM + wr * 64 + fr; const int col0 = u.pn * BM + wc * 32 + 8 * fq;
        u32x4 qa[3][2], qc[3][2];
#define EGD_LOAD(gg) do { const int rw_ = row0 + ((gg) >> 2) * HALF + ((gg) & 3) * 16; \
            _Pragma("unroll") for (int bj = 0; bj < 2; ++bj) { qa[(gg) % 3][bj] = *(const u32x4*)(ga + (size_t)rw_ * ldg + col0 + bj * HALF); qc[(gg) % 3][bj] = *(const u32x4*)(gc + (size_t)rw_ * ldg + col0 + bj * HALF); } } while (0)
        EGD_LOAD(0); EGD_LOAD(1);
#pragma unroll
        for (int g = 0; g < 8; ++g) { const int ai = g >> 2, m = g & 3;
            if (g + 2 < 8) EGD_LOAD(g + 2);
#pragma unroll
            for (int bj = 0; bj < 2; ++bj) { const u32x4 a = qa[g % 3][bj], c = qc[g % 3][bj];
#define EGD_R(av, cv) ((1.0f + em(cv)) * __builtin_amdgcn_rcpf(1.0f + em(av)))
                acc[ai][bj][m][0][0] *= EGD_R(bf_lo(a.x), bf_lo(c.x)); acc[ai][bj][m][0][1] *= EGD_R(bf_hi(a.x), bf_hi(c.x)); acc[ai][bj][m][0][2] *= EGD_R(bf_lo(a.y), bf_lo(c.y)); acc[ai][bj][m][0][3] *= EGD_R(bf_hi(a.y), bf_hi(c.y));
                acc[ai][bj][m][1][0] *= EGD_R(bf_lo(a.z), bf_lo(c.z)); acc[ai][bj][m][1][1] *= EGD_R(bf_hi(a.z), bf_hi(c.z)); acc[ai][bj][m][1][2] *= EGD_R(bf_lo(a.w), bf_lo(c.w)); acc[ai][bj][m][1][3] *= EGD_R(bf_hi(a.w), bf_hi(c.w));
#undef EGD_R
            } }
#undef EGD_LOAD
    }
    __device__ __forceinline__ void operator()(const f32x4 (&acc)[2][2][4][2], const Unit& u, int wr, int wc, int fr, int fq) const {
        const int row0 = u.pm * BM + wr * 64 + fr; const int col0 = u.pn * BM + wc * 32 + 8 * fq;
        u32x4 qc[3][2];
#define EGD_LOAD(gg) do { const int rw_ = row0 + ((gg) >> 2) * HALF + ((gg) & 3) * 16; \
            _Pragma("unroll") for (int bj = 0; bj < 2; ++bj) qc[(gg) % 3][bj] = *(const u32x4*)(gc + (size_t)rw_ * ldg + col0 + bj * HALF); } while (0)
        EGD_LOAD(0); EGD_LOAD(1);
#pragma unroll
        for (int g = 0; g < 8; ++g) { const int ai = g >> 2, m = g & 3; const int row = row0 + ai * HALF + m * 16; bf16_t* rowp = O + (size_t)row * ldc + col0;
            if (g + 2 < 8) EGD_LOAD(g + 2);
#pragma unroll
            for (int bj = 0; bj < 2; ++bj) { f32x4 v0 = acc[ai][bj][m][0], v1 = acc[ai][bj][m][1]; const u32x4 q = qc[g % 3][bj];
                v0[0] *= sigmoidf_fast(bf_lo(q.x)); v0[1] *= sigmoidf_fast(bf_hi(q.x)); v0[2] *= sigmoidf_fast(bf_lo(q.y)); v0[3] *= sigmoidf_fast(bf_hi(q.y));
                v1[0] *= sigmoidf_fast(bf_lo(q.z)); v1[1] *= sigmoidf_fast(bf_hi(q.z)); v1[2] *= sigmoidf_fast(bf_lo(q.w)); v1[3] *= sigmoidf_fast(bf_hi(q.w));
                u32x4 w; w.x = cvt_pk_bf16(v0[0], v0[1]); w.y = cvt_pk_bf16(v0[2], v0[3]); w.z = cvt_pk_bf16(v1[0], v1[1]); w.w = cvt_pk_bf16(v1[2], v1[3]);
                *(u32x4*)(rowp + bj * HALF) = w; } }
#undef EGD_LOAD
    }
};
struct PairedOrder {
    StaticOrder so;
    __host__ __device__ void init(int M, int N, int G_, int c_) { so.init(M, N, G_, c_); }
    __host__ __device__ bool next(int i, Unit& u) const { const bool ok = so.next(i >> 1, u); u.part = i & 1; return ok; }
    __device__ __forceinline__ void a_ready(const Unit&) const {}
    __device__ __forceinline__ void done(const Unit&) const {}
};
struct EpiRes {
    static constexpr bool DUAL = false; static constexpr bool PERM = false, AFTER_DRAIN = false;
    const float* base; float* out; int ldc; const float* bias; float alpha;
    __device__ __forceinline__ void operator()(const f32x4 (&acc)[2][2][4][2], const Unit& u, int wr, int wc, int fr, int fq) const {
        const int col0 = u.pn * BM + wc * 32 + 4 * fq;
        f32x4 bv[2][2];
#pragma unroll
        for (int bj = 0; bj < 2; ++bj)
#pragma unroll
            for (int n = 0; n < 2; ++n) bv[bj][n] = *(const f32x4*)(bias + col0 + bj * HALF + n * 16);
#pragma unroll
        for (int ai = 0; ai < 2; ++ai)
#pragma unroll
            for (int m = 0; m < 4; ++m) { const size_t off = (size_t)(u.pm * BM + ai * HALF + wr * 64 + m * 16 + fr) * ldc + col0;
#pragma unroll
                for (int bj = 0; bj < 2; ++bj)
#pragma unroll
                    for (int n = 0; n < 2; ++n) { const f32x4 bs = *(const f32x4*)(base + off + bj * HALF + n * 16);
                        *(f32x4*)(out + off + bj * HALF + n * 16) = bs * alpha + acc[ai][bj][m][n] + bv[bj][n]; } }
    }
};

__device__ __forceinline__ void stats_mr(const f32x2 s, float& mu, float& r) { mu = s.x * (1.0f / 1024.0f); const float var = s.y * (1.0f / 1024.0f) - mu * mu; r = __builtin_amdgcn_rsqf(var + 1e-5f); }
struct EpiLN {
    static constexpr bool DUAL = false; static constexpr bool PERM = true, AFTER_DRAIN = false;
    bf16_t* O; int ldc; const float* cs; const float* bc; int skip_tile, skip; const float* stats;
    __device__ __forceinline__ void operator()(const f32x4 (&acc)[2][2][4][2], const Unit& u, int wr, int wc, int fr, int fq) const {
        const int row0 = u.pm * BM + wr * 64 + fr; const int col0 = u.pn * BM + wc * 32 + 8 * fq; const int bcol0 = col0 + (u.pn >= skip_tile ? skip : 0);
        f32x2 sv[2][4];
#pragma unroll
        for (int ai = 0; ai < 2; ++ai)
#pragma unroll
            for (int m = 0; m < 4; ++m) sv[ai][m] = *(const f32x2*)(stats + 2 * (size_t)(row0 + ai * HALF + m * 16));
        f32x4 cv[2][2], bv[2][2];
#pragma unroll
        for (int bj = 0; bj < 2; ++bj)
#pragma unroll
            for (int n = 0; n < 2; ++n) { cv[bj][n] = *(const f32x4*)(cs + bcol0 + bj * HALF + 4 * n); bv[bj][n] = *(const f32x4*)(bc + bcol0 + bj * HALF + 4 * n); }
#pragma unroll
        for (int ai = 0; ai < 2; ++ai)
#pragma unroll
            for (int m = 0; m < 4; ++m) { const int row = row0 + ai * HALF + m * 16; bf16_t* rowp = O + (size_t)row * ldc + col0;
                float mu, r; stats_mr(sv[ai][m], mu, r);
#pragma unroll
                for (int bj = 0; bj < 2; ++bj) { const f32x4 v0 = (acc[ai][bj][m][0] - cv[bj][0] * mu) * r + bv[bj][0], v1 = (acc[ai][bj][m][1] - cv[bj][1] * mu) * r + bv[bj][1];
                    u32x4 w; w.x = cvt_pk_bf16(v0[0], v0[1]); w.y = cvt_pk_bf16(v0[2], v0[3]); w.z = cvt_pk_bf16(v1[0], v1[1]); w.w = cvt_pk_bf16(v1[2], v1[3]);
                    *(u32x4*)(rowp + bj * HALF) = w; } }
    }
};
struct EpiLNT {
    static constexpr bool DUAL = false; static constexpr bool PERM = true, AFTER_DRAIN = false;
    bf16_t* O; int ldc; const float* cs; const float* bc; const float* stats;
    __device__ __forceinline__ void operator()(const f32x4 (&acc)[2][2][4][2], const Unit& u, int wr, int wc, int fr, int fq) const {
        const int row0 = u.pm * BM + wr * 64 + fr; const int col0 = u.pn * BM + wc * 32 + 8 * fq;
        f32x4 sq[2][4]; float cr[2][4], br[2][4];
#pragma unroll
        for (int bj = 0; bj < 2; ++bj)
#pragma unroll
            for (int q = 0; q < 4; ++q) sq[bj][q] = *(const f32x4*)(stats + 2 * (size_t)(col0 + bj * HALF) + 4 * q);
#pragma unroll
        for (int ai = 0; ai < 2; ++ai)
#pragma unroll
            for (int m = 0; m < 4; ++m) { cr[ai][m] = cs[row0 + ai * HALF + m * 16]; br[ai][m] = bc[row0 + ai * HALF + m * 16]; }
        float mu[2][8], r[2][8];
#pragma unroll
        for (int bj = 0; bj < 2; ++bj)
#pragma unroll
            for (int q = 0; q < 4; ++q) { stats_mr((f32x2){sq[bj][q][0], sq[bj][q][1]}, mu[bj][2 * q], r[bj][2 * q]); stats_mr((f32x2){sq[bj][q][2], sq[bj][q][3]}, mu[bj][2 * q + 1], r[bj][2 * q + 1]); }
#pragma unroll
        for (int ai = 0; ai < 2; ++ai)
#pragma unroll
            for (int m = 0; m < 4; ++m) { const int row = row0 + ai * HALF + m * 16; bf16_t* rowp = O + (size_t)row * ldc + col0; const float c = cr[ai][m], b = br[ai][m];
#pragma unroll
                for (int bj = 0; bj < 2; ++bj) { float v[8];
#pragma unroll
                    for (int e = 0; e < 8; ++e) v[e] = (acc[ai][bj][m][e >> 2][e & 3] - c * mu[bj][e]) * r[bj][e] + b;
                    u32x4 w; w.x = cvt_pk_bf16(v[0], v[1]); w.y = cvt_pk_bf16(v[2], v[3]); w.z = cvt_pk_bf16(v[4], v[5]); w.w = cvt_pk_bf16(v[6], v[7]);
                    *(u32x4*)(rowp + bj * HALF) = w; } }
    }
};
struct EpiRes2 {
    static constexpr bool DUAL = false; static constexpr bool PERM = true, AFTER_DRAIN = false;
    const float* base; float* out; bf16_t* zb; int ldc; const float* bias; const float* bstats; const float* bg; const float* bb; float* ostats;
    __device__ __forceinline__ void operator()(const f32x4 (&acc)[2][2][4][2], const Unit& u, int wr, int wc, int fr, int fq) const {
        constexpr float alpha = 1.41421356237309515f;
        const int urow = u.pm * BM + wr * 64, ucol = u.pn * BM + wc * 32;
        const size_t ubase = (size_t)urow * ldc + ucol;
        const char* bp = (const char*)(base + ubase); char* op = (char*)(out + ubase); char* zp = (char*)(zb + ubase);
        const char* sp = (const char*)(bstats + 2 * (size_t)urow); float* osp = ostats + 2 * (size_t)urow;
        const unsigned l4 = (unsigned)(fr * ldc + 8 * fq) * 4u, l2 = (unsigned)(fr * ldc + 8 * fq) * 2u, ls = (unsigned)fr * 8u;
        const int col0 = ucol + 8 * fq;
        f32x4 gv[2][2], cv[2][2];
#pragma unroll
        for (int bj = 0; bj < 2; ++bj)
#pragma unroll
            for (int n = 0; n < 2; ++n) { gv[bj][n] = *(const f32x4*)(bg + col0 + bj * HALF + 4 * n) * alpha;
                cv[bj][n] = *(const f32x4*)(bb + col0 + bj * HALF + 4 * n) * alpha + *(const f32x4*)(bias + col0 + bj * HALF + 4 * n); }
        f32x2 sv_c = *(const f32x2*)(sp + ls);
        f32x4 p0 = *(const f32x4*)(bp + l4), p1 = *(const f32x4*)(bp + l4 + 16);
#pragma unroll
        for (int g = 0; g < 8; ++g) { const int ai = g >> 2, m = g & 3; const int rr = ai * HALF + m * 16, rn = ((g + 1) >> 2) * HALF + ((g + 1) & 3) * 16;
            f32x2 sv_n = sv_c; if (g + 1 < 8) sv_n = *(const f32x2*)(sp + (size_t)rn * 8 + ls);
            float mu, r; stats_mr(sv_c, mu, r); float s1 = 0.f, s2 = 0.f;
#pragma unroll
            for (int bj = 0; bj < 2; ++bj) { const size_t ro = (size_t)rr * ldc + bj * HALF;
                f32x4 q0 = p0, q1 = p1;
                if (bj == 0) { q0 = *(const f32x4*)(bp + (ro + HALF) * 4 + l4); q1 = *(const f32x4*)(bp + (ro + HALF) * 4 + l4 + 16); }
                else if (g + 1 < 8) { q0 = *(const f32x4*)(bp + (size_t)rn * ldc * 4 + l4); q1 = *(const f32x4*)(bp + (size_t)rn * ldc * 4 + l4 + 16); }
                const f32x4 z0 = gv[bj][0] * ((p0 - mu) * r) + acc[ai][bj][m][0] + cv[bj][0], z1 = gv[bj][1] * ((p1 - mu) * r) + acc[ai][bj][m][1] + cv[bj][1];
                *(f32x4*)(op + ro * 4 + l4) = z0; *(f32x4*)(op + ro * 4 + l4 + 16) = z1;
                s1 += ((z0[0] + z0[1]) + (z0[2] + z0[3])) + ((z1[0] + z1[1]) + (z1[2] + z1[3]));
                s2 += ((z0[0] * z0[0] + z0[1] * z0[1]) + (z0[2] * z0[2] + z0[3] * z0[3])) + ((z1[0] * z1[0] + z1[1] * z1[1]) + (z1[2] * z1[2] + z1[3] * z1[3]));
                if (zb) { u32x4 w; w.x = cvt_pk_bf16(z0[0], z0[1]); w.y = cvt_pk_bf16(z0[2], z0[3]); w.z = cvt_pk_bf16(z1[0], z1[1]); w.w = cvt_pk_bf16(z1[2], z1[3]); *(u32x4*)(zp + ro * 2 + l2) = w; }
                p0 = q0; p1 = q1; }
            s1 += __shfl_xor(s1, 16); s2 += __shfl_xor(s2, 16); s1 += __shfl_xor(s1, 32); s2 += __shfl_xor(s2, 32);
            if (fq == 0) { atomicAdd(osp + 2 * (rr + fr), s1); atomicAdd(osp + 2 * (rr + fr) + 1, s2); }
            sv_c = sv_n; }
    }
};
}
#define LAS __attribute__((address_space(3)))
typedef unsigned short bf16;
typedef unsigned v4u __attribute__((ext_vector_type(4)));
typedef unsigned v2u __attribute__((ext_vector_type(2)));
typedef float f32x4 __attribute__((ext_vector_type(4)));
typedef short bf16x8 __attribute__((ext_vector_type(8)));
constexpr int NWAVES = 8, NTHR = 512;
constexpr int DM = 1024, MC = 32768, NCHUNK = 3, NLAYER = 2;
constexpr int PW = 4608;
constexpr int AW = 512, DFF = 2816, NUP = 5632, PROJ_W = 5120;
constexpr int C_Q = 0, C_K = 512, C_U = 1024, C_GB = 1536, C_GC = 2048, C_GA = 2560, C_GCC = 3584;
constexpr float ALPHA = 1.41421356237309515f, LN_EPS = 1e-5f, LOG2E = 1.4426950408889634f;
constexpr size_t OFF_WIN = 0, OFF_WV = OFF_WIN + (size_t)PW * DM, OFF_WA = OFF_WV + (size_t)AW * DM, OFF_WC = OFF_WA + (size_t)DM * AW,
                 OFF_WO = OFF_WC + (size_t)DM * AW, OFF_WUP = OFF_WO + (size_t)DM * DM, OFF_WDN = OFF_WUP + (size_t)NUP * DM, W_LAYER = (size_t)16 << 20;
static_assert(OFF_WDN + (size_t)DM * DFF <= W_LAYER, "weights per layer");
constexpr size_t MiB = (size_t)1 << 20;
constexpr size_t WS_W = 0, WS_XB = 64 * MiB, WS_PROJ = 128 * MiB, WS_VT = 416 * MiB, WS_YA = 448 * MiB, WS_YC = 480 * MiB, WS_MG = 512 * MiB,
                 WS_H = 128 * MiB, WS_G = 576 * MiB, WS_ZERO = 752 * MiB, ZERO_BYTES = 4 * MiB, WS_ST = WS_ZERO, WS_CS = WS_ZERO + 3 * MiB, WS_BAR = WS_ZERO + 3 * MiB + 512 * 1024, WS_ID = 756 * MiB, WS_END = 757 * MiB;
constexpr int CS_IN = 0, BC_IN = 5120, CS_UP = 10240, BC_UP = 10240 + 5632, CS_LAYER = 10240 + 2 * 5632;
static_assert((size_t)NCHUNK * NLAYER * 2 * MC * 2 * 4 <= 3 * MiB && (size_t)NLAYER * CS_LAYER * 4 <= MiB, "zeroed region");
static_assert(WS_PROJ + (size_t)MC * PW * 2 <= WS_VT && WS_H + (size_t)MC * NUP * 2 <= WS_YC && WS_G + (size_t)MC * DFF * 2 <= WS_ZERO, "ws map");
constexpr int LDS_BYTES = 147456;

__device__ __forceinline__ unsigned f2bf(float f) { unsigned u = __builtin_bit_cast(unsigned, f); return (u + 0x7fffu + ((u >> 16) & 1u)) >> 16; }
__device__ __forceinline__ unsigned pk2(float lo, float hi) { return f2bf(lo) | (f2bf(hi) << 16); }
__device__ __forceinline__ float wave_sum(float v) {
#pragma unroll
    for (int o = 1; o < 64; o <<= 1) v += __shfl_xor(v, o);
    return v;
}
using pg8::bf_lo; using pg8::bf_hi; using pg8::cvt_pk_bf16;

__device__ __forceinline__ void transpose_item(const float* W, int K, int N, bf16* WT, int rowadj, LAS float* scr, int item, int lane,
                                               const float* gk, const float* bk, const float* bias, float* cs, float* bc) {
    const int nblk = N / 32, kb = item / nblk, nb = item % nblk, k0 = 64 * kb, n0 = 32 * nb;
    float pcs = 0.f, pbc = 0.f;
    float wl_[32];
#pragma unroll
    for (int i = 0; i < 32; ++i) wl_[i] = __builtin_nontemporal_load(W + (size_t)(k0 + 2 * i + (lane >> 5)) * N + n0 + (lane & 31));
#pragma unroll
    for (int i = 0; i < 32; ++i) { const int kk = 2 * i + (lane >> 5); const float w = wl_[i];
        float wg = w; if (gk) wg = w * gk[k0 + kk]; scr[kk * 33 + (lane & 31)] = wg;
        if (cs) { pcs += __builtin_bit_cast(float, f2bf(wg) << 16); if (bk) pbc += bk[k0 + kk] * w; } }
    if (cs) { pcs += __shfl_xor(pcs, 32); pbc += __shfl_xor(pbc, 32); if (kb == 0) pbc += bias[n0 + (lane & 31)];
        if (lane < 32) { atomicAdd(cs + n0 + lane, pcs); atomicAdd(bc + n0 + lane, pbc); } }
    asm volatile("s_waitcnt lgkmcnt(0)" ::: "memory");
    const int c = lane & 7;
#pragma unroll
    for (int j = 0; j < 4; ++j) { const int n = (lane >> 3) + 8 * j; const LAS float* s = scr + (8 * c) * 33 + n;
        v4u o; o.x = pk2(s[0 * 33], s[1 * 33]); o.y = pk2(s[2 * 33], s[3 * 33]); o.z = pk2(s[4 * 33], s[5 * 33]); o.w = pk2(s[6 * 33], s[7 * 33]);
        *(v4u*)(WT + (size_t)(n0 + n + rowadj) * K + k0 + 8 * c) = o; }
    asm volatile("s_waitcnt lgkmcnt(0)" ::: "memory");
}

__device__ __forceinline__ const float* idptr(const unsigned char* ws, int off) { asm volatile("" : "+s"(off)); return (const float*)(ws + WS_ID) + off; }
struct Args { const float* in[21]; float* out; unsigned char* ws; int ph_lo, ph_hi; };
__device__ __forceinline__ const float* ldin(const Args& a, int i) { asm volatile("" : "+s"(i)); return a.in[i]; }

__device__ __forceinline__ void prologue_weights(const Args& a, LAS unsigned char* lds, int gw, int NGW, int wave, int lane) {
    LAS float* scr = (LAS float*)(lds + wave * 16384);
    constexpr int I_IN = (DM / 64) * (PROJ_W / 32), I_BR = (AW / 64) * (DM / 32), I_O = (DM / 64) * (DM / 32), I_UP = (DM / 64) * (NUP / 32), I_DN = (DFF / 64) * (DM / 32);
    constexpr int PER_LAYER = I_IN + 2 * I_BR + I_O + I_UP + I_DN;
    for (int it = gw; it < NLAYER * PER_LAYER; it += NGW) {
        const int l = it / PER_LAYER; int r = it % PER_LAYER;
        bf16* wl = (bf16*)(a.ws + WS_W) + (size_t)l * W_LAYER;
        float* csl = (float*)(a.ws + WS_CS) + (size_t)l * CS_LAYER;
        if (r < I_IN) { const int nb = r % (PROJ_W / 32), n0 = nb * 32; const float* W = ldin(a, 2) + (size_t)l * DM * PROJ_W;
            const float* gk = l > 0 ? ldin(a, 19) + (size_t)(l - 1) * DM : nullptr; const float* bk = l > 0 ? ldin(a, 20) + (size_t)(l - 1) * DM : nullptr;
            bf16* dst = (n0 >= 1024 && n0 < 1536) ? wl + OFF_WV : wl + OFF_WIN; const int adj = n0 < 1024 ? 0 : (n0 < 1536 ? -1024 : -512);
            transpose_item(W, DM, PROJ_W, dst, adj, scr, r, lane, gk, bk, ldin(a, 3) + (size_t)l * PROJ_W, csl + CS_IN, csl + BC_IN);
            continue; } r -= I_IN;
        if (r < I_BR) { transpose_item(ldin(a, 7) + (size_t)l * AW * DM, AW, DM, wl + OFF_WA, 0, scr, r, lane, nullptr, nullptr, nullptr, nullptr, nullptr); continue; } r -= I_BR;
        if (r < I_BR) { transpose_item(ldin(a, 8) + (size_t)l * AW * DM, AW, DM, wl + OFF_WC, 0, scr, r, lane, nullptr, nullptr, nullptr, nullptr, nullptr); continue; } r -= I_BR;
        if (r < I_O) { transpose_item(ldin(a, 9) + (size_t)l * DM * DM, DM, DM, wl + OFF_WO, 0, scr, r, lane, nullptr, nullptr, nullptr, nullptr, nullptr); continue; } r -= I_O;
        if (r < I_UP) { transpose_item(ldin(a, 13) + (size_t)l * DM * NUP, DM, NUP, wl + OFF_WUP, 0, scr, r, lane, ldin(a, 11) + (size_t)l * DM, ldin(a, 12) + (size_t)l * DM,
                                       ldin(a, 14) + (size_t)l * NUP, csl + CS_UP, csl + BC_UP); continue; } r -= I_UP;
        transpose_item(ldin(a, 17) + (size_t)l * DFF * DM, DFF, DM, wl + OFF_WDN, 0, scr, r, lane, nullptr, nullptr, nullptr, nullptr, nullptr);
    }
}
__device__ __forceinline__ void convert_rows(const float* x, bf16* xb, int nrows, int vcu, int NGW) {
    int t_ = threadIdx.x; asm volatile("" : "+v"(t_)); const int lane = t_ & 63, gw = vcu * NWAVES + __builtin_amdgcn_readfirstlane(t_ >> 6);
    for (int m = gw * 4; m < nrows; m += NGW * 4) {
        f32x4 v[4][4];
#pragma unroll
        for (int q = 0; q < 4; ++q) { const f32x4* xr = (const f32x4*)(x + (size_t)(m + q) * DM) + lane;
#pragma unroll
            for (int j = 0; j < 4; ++j) v[q][j] = __builtin_nontemporal_load(xr + 64 * j); }
#pragma unroll
        for (int q = 0; q < 4; ++q) { v2u* o = (v2u*)(xb + (size_t)(m + q) * DM) + lane;
#pragma unroll
            for (int j = 0; j < 4; ++j) { v2u w; w.x = cvt_pk_bf16(v[q][j][0], v[q][j][1]); w.y = cvt_pk_bf16(v[q][j][2], v[q][j][3]); o[64 * j] = w; } }
    }
}
__device__ __forceinline__ void ln_rows(float* z, bf16* xb, const float* g, const float* b, int nrows, int vcu, int NGW, bool write_xb) {
    int t_ = threadIdx.x; asm volatile("" : "+v"(t_)); const int lane = t_ & 63, gw = vcu * NWAVES + __builtin_amdgcn_readfirstlane(t_ >> 6);
    f32x4 gv[4], bv[4];
#pragma unroll
    for (int j = 0; j < 4; ++j) { gv[j] = ((const f32x4*)g)[64 * j + lane]; bv[j] = ((const f32x4*)b)[64 * j + lane]; }
    for (int m = gw * 2; m < nrows; m += NGW * 2) {
        f32x4 v[2][4];
#pragma unroll
        for (int q = 0; q < 2; ++q) { const f32x4* xr = (const f32x4*)(z + (size_t)(m + q) * DM) + lane;
#pragma unroll
            for (int j = 0; j < 4; ++j) v[q][j] = xr[64 * j]; }
#pragma unroll
        for (int q = 0; q < 2; ++q) { f32x4* xr = (f32x4*)(z + (size_t)(m + q) * DM) + lane; v2u* o = (v2u*)(xb + (size_t)(m + q) * DM) + lane;
            float s = 0.f;
#pragma unroll
            for (int j = 0; j < 4; ++j) s += (v[q][j][0] + v[q][j][1]) + (v[q][j][2] + v[q][j][3]);
            const float mean = wave_sum(s) * (1.f / DM); float s2 = 0.f;
#pragma unroll
            for (int j = 0; j < 4; ++j) { v[q][j] = v[q][j] - mean; s2 += (v[q][j][0] * v[q][j][0] + v[q][j][1] * v[q][j][1]) + (v[q][j][2] * v[q][j][2] + v[q][j][3] * v[q][j][3]); }
            const float rstd = 1.f / sqrtf(wave_sum(s2) * (1.f / DM) + LN_EPS);
#pragma unroll
            for (int j = 0; j < 4; ++j) { const f32x4 y = v[q][j] * rstd * gv[j] + bv[j]; xr[64 * j] = y;
                if (write_xb) { v2u w; w.x = cvt_pk_bf16(y[0], y[1]); w.y = cvt_pk_bf16(y[2], y[3]); o[64 * j] = w; } } }
    }
}
__device__ __forceinline__ void unpack8(const v4u w, float (&f)[8]) {
    f[0] = bf_lo(w.x); f[1] = bf_hi(w.x); f[2] = bf_lo(w.y); f[3] = bf_hi(w.y); f[4] = bf_lo(w.z); f[5] = bf_hi(w.z); f[6] = bf_lo(w.w); f[7] = bf_hi(w.w);
}
__device__ __forceinline__ void convbranch_phase(const bf16* proj, bf16* yc, const float* cw, const float* cb, int T, int vcu, int NT) {
    int t_ = threadIdx.x; asm volatile("" : "+v"(t_)); const int gtid = vcu * NTHR + t_;
    constexpr int NG = AW / 8, L = 16, R = MC / L;
    for (int item = gtid; item < NG * R; item += NT) {
        const int run = item / NG, ch = (item - run * NG) * 8, t0 = run * L;
        float w0[8], w1[8], w2[8], bb[8];
#pragma unroll
        for (int e = 0; e < 8; e += 4) { *(f32x4*)(w0 + e) = *(const f32x4*)(cw + ch + e); *(f32x4*)(w1 + e) = *(const f32x4*)(cw + AW + ch + e);
            *(f32x4*)(w2 + e) = *(const f32x4*)(cw + 2 * AW + ch + e); *(f32x4*)(bb + e) = *(const f32x4*)(cb + ch + e); }
        const bf16* p = proj + (size_t)t0 * PW + ch;
        float pp[8], pc[8], fu[8], fc[8];
        { unpack8(*(const v4u*)(p + C_U), fu); unpack8(*(const v4u*)(p + C_GC), fc);
#pragma unroll
          for (int e = 0; e < 8; ++e) pc[e] = fu[e] * fc[e]; }
        if (t0 > 0) { unpack8(*(const v4u*)(p - PW + C_U), fu); unpack8(*(const v4u*)(p - PW + C_GC), fc);
#pragma unroll
          for (int e = 0; e < 8; ++e) pp[e] = fu[e] * fc[e]; }
        else {
#pragma unroll
          for (int e = 0; e < 8; ++e) pp[e] = 0.f; }
        for (int t = t0; t < t0 + L; t += 4) {
            const v4u z4 = (v4u){0u, 0u, 0u, 0u}; v4u un[4], cn[4], gq[4];
#pragma unroll
            for (int q = 0; q < 4; ++q) { un[q] = z4; cn[q] = z4; gq[q] = *(const v4u*)(p + (size_t)q * PW + C_GB);
                if (t + q + 1 < MC) { un[q] = *(const v4u*)(p + (size_t)(q + 1) * PW + C_U); cn[q] = *(const v4u*)(p + (size_t)(q + 1) * PW + C_GC); } }
#pragma unroll
            for (int q = 0; q < 4; ++q) { const int tpos = (t + q) & (T - 1);
                float fg[8], pn[8], r[8]; unpack8(gq[q], fg); unpack8(un[q], fu); unpack8(cn[q], fc);
                const float mp = tpos == 0 ? 0.f : 1.f, mn = tpos == T - 1 ? 0.f : 1.f;
#pragma unroll
                for (int e = 0; e < 8; ++e) { pn[e] = fu[e] * fc[e]; r[e] = fg[e] * (w0[e] * (pp[e] * mp) + w1[e] * pc[e] + w2[e] * (pn[e] * mn) + bb[e]); pp[e] = pc[e]; pc[e] = pn[e]; }
                v4u o; o.x = cvt_pk_bf16(r[0], r[1]); o.y = cvt_pk_bf16(r[2], r[3]); o.z = cvt_pk_bf16(r[4], r[5]); o.w = cvt_pk_bf16(r[6], r[7]);
                *(v4u*)(yc + (size_t)(t + q) * AW + ch) = o; }
            p += 4 * (size_t)PW;
        }
    }
}
__device__ __forceinline__ float gelu_tanh(float x) {
    const float u = x * (0.7978845608028654f + 0.035677408136300125f * x * x);
    return x * __builtin_amdgcn_rcpf(1.0f + __builtin_amdgcn_exp2f(-2.0f * LOG2E * u));
}
__device__ __forceinline__ void ffnconv_phase(const bf16* h, bf16* gout, const float* cw, const float* cb, int T, int vcu, int NT) {
    int t_ = threadIdx.x; asm volatile("" : "+v"(t_)); const int gtid = vcu * NTHR + t_;
    constexpr int NG = DFF / 8, L = 96, R = (MC + L - 1) / L, RS = 8;
    static_assert(L % RS == 0 && MC % RS == 0, "rows are walked RS at a time");
    for (int item = gtid; item < NG * R; item += NT) {
        const int run = item / NG, ch = (item - run * NG) * 8, t0 = run * L, t1 = (t0 + L < MC) ? t0 + L : MC;
        float wg0[8], wg1[8], wg2[8], bg[8], wv0[8], wv1[8], wv2[8], bv[8];
#pragma unroll
        for (int e = 0; e < 8; e += 4) {
            *(f32x4*)(wg0 + e) = *(const f32x4*)(cw + ch + e); *(f32x4*)(wg1 + e) = *(const f32x4*)(cw + NUP + ch + e); *(f32x4*)(wg2 + e) = *(const f32x4*)(cw + 2 * NUP + ch + e); *(f32x4*)(bg + e) = *(const f32x4*)(cb + ch + e);
            *(f32x4*)(wv0 + e) = *(const f32x4*)(cw + DFF + ch + e); *(f32x4*)(wv1 + e) = *(const f32x4*)(cw + NUP + DFF + ch + e); *(f32x4*)(wv2 + e) = *(const f32x4*)(cw + 2 * NUP + DFF + ch + e); *(f32x4*)(bv + e) = *(const f32x4*)(cb + DFF + ch + e); }
        const bf16* p = h + (size_t)t0 * NUP + ch;
        const v4u z4 = (v4u){0u, 0u, 0u, 0u};
        v4u gp_ = z4, vp_ = z4, gc_ = *(const v4u*)(p), vc_ = *(const v4u*)(p + DFF);
        if (t0 > 0) { gp_ = *(const v4u*)(p - NUP); vp_ = *(const v4u*)(p - NUP + DFF); }
        for (int t = t0; t < t1; t += RS) {
            v4u gn_[RS], vn_[RS];
#pragma unroll
            for (int q = 0; q < RS; ++q) { gn_[q] = z4; vn_[q] = z4; if (t + q + 1 < MC) { gn_[q] = __builtin_nontemporal_load((const v4u*)(p + (size_t)(q + 1) * NUP)); vn_[q] = __builtin_nontemporal_load((const v4u*)(p + (size_t)(q + 1) * NUP + DFF)); } }
#pragma unroll
            for (int q = 0; q < RS; ++q) {
                const int tpos = (t + q) & (T - 1);
                const float mp = tpos == 0 ? 0.f : 1.f, mn = tpos == T - 1 ? 0.f : 1.f;
                float a0[8], a1[8], a2[8], b0[8], b1[8], b2[8], r[8];
                unpack8(gp_, a0); unpack8(gc_, a1); unpack8(gn_[q], a2); unpack8(vp_, b0); unpack8(vc_, b1); unpack8(vn_[q], b2);
#pragma unroll
                for (int e = 0; e < 8; ++e) { const float hg = wg0[e] * (a0[e] * mp) + wg1[e] * a1[e] + wg2[e] * (a2[e] * mn) + bg[e];
                    const float hv = wv0[e] * (b0[e] * mp) + wv1[e] * b1[e] + wv2[e] * (b2[e] * mn) + bv[e]; r[e] = gelu_tanh(hg) * hv; }
                v4u o; o.x = cvt_pk_bf16(r[0], r[1]); o.y = cvt_pk_bf16(r[2], r[3]); o.z = cvt_pk_bf16(r[4], r[5]); o.w = cvt_pk_bf16(r[6], r[7]);
                *(v4u*)(gout + (size_t)(t + q) * DFF + ch) = o;
                gp_ = gc_; gc_ = gn_[q]; vp_ = vc_; vc_ = vn_[q]; }
            p += RS * (size_t)NUP;
        }
    }
}
__device__ __forceinline__ void attn_phase(const bf16* __restrict__ proj, const bf16* __restrict__ vt, bf16* __restrict__ ya, const float* __restrict__ rpb, int T, int vcu, int G, LAS unsigned char* lds) {
    int t_ = threadIdx.x; asm volatile("" : "+v"(t_)); const int lane = t_ & 63, wave = __builtin_amdgcn_readfirstlane(t_ >> 6);
    LAS float* tbl = (LAS float*)lds;
    for (int idx = wave * 64 + lane; idx < 8 * 15 * 31; idx += NTHR) tbl[idx] = rpb[idx] * LOG2E;
    __syncthreads();
    const int rows = T >> 6, nrgp = rows >> 4;
    const int n = lane & 15, q4 = lane >> 4, c = wave & 3, q0 = c * 16, cs = (c == 0) ? 0 : (c == 1) ? 8 : (c == 2) ? 24 : 32;
    const float SC = 0.125f * LOG2E;
    const unsigned qlane = (unsigned)(n * PW + 8 * q4) * 2u, klane = (unsigned)((8 * (n >> 2) + (n & 3)) * PW + 8 * q4) * 2u, vlane = (unsigned)(n * MC + 8 * q4) * 2u, olane = (unsigned)(n * AW + 4 * q4) * 2u;
    unsigned dpack0 = 0u, dpack1 = 0u, vmask = 0u;
    { const int qj = q0 + n; int js = qj - 8; js = js < 0 ? 0 : js; js = js > 48 ? 48 : js;
#pragma unroll
      for (int hf = 0; hf < 2; ++hf)
#pragma unroll
          for (int j = 0; j < 4; ++j) { const int kj = cs + 8 * q4 + 4 * hf + j; const bool v = (kj >= js) && (kj < js + 16); int dc = kj - qj + 15; dc = dc < 0 ? 0 : dc; dc = dc > 30 ? 30 : dc;
              if (hf == 0) dpack0 |= (unsigned)dc << (8 * j); else dpack1 |= (unsigned)dc << (8 * j); vmask |= (v ? 1u : 0u) << (hf * 4 + j); } }
    asm volatile("" : "+v"(dpack0), "+v"(dpack1), "+v"(vmask));
    for (int wt = vcu; wt < 256; wt += G) {
        const int rgp = wt % nrgp, h = (wt / nrgp) & 7, s = wt / (nrgp * 8), rg = rgp * 2 + (wave >> 2);
        const LAS float* tbh = tbl + h * 15 * 31;
        for (int pass = 0; pass < 2; ++pass) {
            const int i0 = rg * 8 + pass * 4;
            int rsj[4];
#pragma unroll
            for (int j = 0; j < 4; ++j) { int r_ = i0 + j - 4; r_ = r_ < 0 ? 0 : r_; r_ = r_ > rows - 8 ? rows - 8 : r_; rsj[j] = r_; }
            const int ka0 = rsj[0], ka1 = rsj[3] + 7;
            const size_t tok0 = (size_t)s * T;
            bf16x8 qf[4][2];
#pragma unroll
            for (int j = 0; j < 4; ++j) { const char* qb = (const char*)(proj + (tok0 + (size_t)(i0 + j) * 64 + q0) * PW + C_Q + h * 64); qf[j][0] = *(const bf16x8*)(qb + qlane); qf[j][1] = *(const bf16x8*)(qb + qlane + 64); }
            const char* kb = (const char*)(proj + (tok0 + cs) * PW + C_K + h * 64);
            const char* vb = (const char*)(vt + (size_t)(h * 64) * MC + tok0 + cs);
            f32x4 o[4][4]; float mrun[4], lrun[4];
#pragma unroll
            for (int j = 0; j < 4; ++j) { mrun[j] = -INFINITY; lrun[j] = 0.f;
#pragma unroll
                for (int dt = 0; dt < 4; ++dt) o[j][dt] = (f32x4){0.f, 0.f, 0.f, 0.f}; }
            bf16x8 kf[2][2]; v4u vf[4];
            { const char* kp = kb + (size_t)ka0 * 64 * PW * 2;
#pragma unroll
              for (int hf = 0; hf < 2; ++hf) { kf[hf][0] = *(const bf16x8*)(kp + (size_t)(4 * hf) * PW * 2 + klane); kf[hf][1] = *(const bf16x8*)(kp + (size_t)(4 * hf) * PW * 2 + klane + 64); }
            }
            for (int ka = ka0; ka <= ka1; ++ka) {
                bf16x8 kn[2][2];
#pragma unroll
                for (int hf = 0; hf < 2; ++hf) { kn[hf][0] = kf[hf][0]; kn[hf][1] = kf[hf][1]; }
                { const char* vp = vb + (size_t)ka * 64 * 2;
#pragma unroll
                  for (int dt = 0; dt < 4; ++dt) vf[dt] = *(const v4u*)(vp + (size_t)(16 * dt) * MC * 2 + vlane); }
                if (ka < ka1) { const char* kp = kb + (size_t)(ka + 1) * 64 * PW * 2;
#pragma unroll
                    for (int hf = 0; hf < 2; ++hf) { kn[hf][0] = *(const bf16x8*)(kp + (size_t)(4 * hf) * PW * 2 + klane); kn[hf][1] = *(const bf16x8*)(kp + (size_t)(4 * hf) * PW * 2 + klane + 64); } }
#pragma unroll
                for (int j = 0; j < 4; ++j) { const int kr = ka - rsj[j];
                    if (kr >= 0 && kr < 8) {
                        f32x4 st[2];
#pragma unroll
                        for (int hf = 0; hf < 2; ++hf) { const f32x4 t = __builtin_amdgcn_mfma_f32_16x16x32_bf16(kf[hf][0], qf[j][0], (f32x4){0.f, 0.f, 0.f, 0.f}, 0, 0, 0);
                            st[hf] = __builtin_amdgcn_mfma_f32_16x16x32_bf16(kf[hf][1], qf[j][1], t, 0, 0, 0); }
                        const LAS float* tb = tbh + (ka - i0 - j + 7) * 31;
                        float mloc = -INFINITY;
#pragma unroll
                        for (int hf = 0; hf < 2; ++hf)
#pragma unroll
                            for (int e = 0; e < 4; ++e) { const unsigned dc = ((hf == 0 ? dpack0 : dpack1) >> (8 * e)) & 0xffu; const float b = tb[dc];
                                const float v = ((vmask >> (hf * 4 + e)) & 1u) ? st[hf][e] * SC + b : -INFINITY; st[hf][e] = v; mloc = fmaxf(mloc, v); }
                        mloc = fmaxf(mloc, __shfl_xor(mloc, 16)); mloc = fmaxf(mloc, __shfl_xor(mloc, 32));
                        const float mnew = fmaxf(mrun[j], mloc), alpha = __builtin_amdgcn_exp2f(mrun[j] - mnew); mrun[j] = mnew;
                        float p[8], psum = 0.f;
#pragma unroll
                        for (int hf = 0; hf < 2; ++hf)
#pragma unroll
                            for (int e = 0; e < 4; ++e) { p[hf * 4 + e] = __builtin_amdgcn_exp2f(st[hf][e] - mnew); psum += p[hf * 4 + e]; }
                        lrun[j] = lrun[j] * alpha + psum;
                        v4u w; w.x = cvt_pk_bf16(p[0], p[1]); w.y = cvt_pk_bf16(p[2], p[3]); w.z = cvt_pk_bf16(p[4], p[5]); w.w = cvt_pk_bf16(p[6], p[7]);
                        const bf16x8 pk = __builtin_bit_cast(bf16x8, w);
#pragma unroll
                        for (int dt = 0; dt < 4; ++dt) o[j][dt] = __builtin_amdgcn_mfma_f32_16x16x32_bf16(__builtin_bit_cast(bf16x8, vf[dt]), pk, o[j][dt] * alpha, 0, 0, 0);
                    } }
#pragma unroll
                for (int hf = 0; hf < 2; ++hf) { kf[hf][0] = kn[hf][0]; kf[hf][1] = kn[hf][1]; }
            }
#pragma unroll
            for (int j = 0; j < 4; ++j) { float l = lrun[j]; l += __shfl_xor(l, 16); l += __shfl_xor(l, 32); const float inv = 1.0f / l;
                char* ob = (char*)(ya + (tok0 + (size_t)(i0 + j) * 64 + q0) * AW + h * 64);
#pragma unroll
                for (int dt = 0; dt < 4; ++dt) { v2u w; w.x = cvt_pk_bf16(o[j][dt][0] * inv, o[j][dt][1] * inv); w.y = cvt_pk_bf16(o[j][dt][2] * inv, o[j][dt][3] * inv); *(v2u*)(ob + olane + 32 * dt) = w; } }
        }
    }
}
#define XB_TMO      128
#define XB_XCNT(j)  (256  + 64 * (j))
#define XB_XSUB(j)  (1280 + 64 * (j))
#define XB_XGEN(j)  (2304 + 64 * (j))
#define XB_TOP      3328
#define XB_TOPGEN   3392
#define XCD_BAR_WORDS 3456
#define XB_SPIN_CAP (1u << 18)

__device__ __forceinline__ unsigned xb_ld(unsigned* p)              { return __hip_atomic_load(p, __ATOMIC_RELAXED, __HIP_MEMORY_SCOPE_AGENT); }
__device__ __forceinline__ unsigned xb_add(unsigned* p, unsigned v) { return __hip_atomic_fetch_add(p, v, __ATOMIC_RELAXED, __HIP_MEMORY_SCOPE_AGENT); }
__device__ __forceinline__ unsigned xb_xcc_id() { return (unsigned)__builtin_amdgcn_s_getreg((3 << 11) | 20) & 0xFu; }
#define XB_SPIN(cond, bar) do { unsigned _sp = 0; while (cond) { __builtin_amdgcn_s_sleep(1); \
    if ((++_sp & 255u) == 0u) { if (xb_ld(&(bar)[XB_TMO])) break; if (_sp > XB_SPIN_CAP) { atomicAdd(&(bar)[XB_TMO], 1u); break; } } } } while (0)

struct XcdBarrier {
    unsigned* bar; unsigned x;
    volatile LAS unsigned* st;
};

__device__ __forceinline__ XcdBarrier xcd_barrier_post(unsigned* bar, volatile LAS unsigned* st) {
    XcdBarrier b; b.bar = bar; b.x = xb_xcc_id(); b.st = st;
    if (threadIdx.x == 0) (void)xb_add(&bar[XB_XCNT(b.x)], 1u);
    return b;
}
__device__ __forceinline__ void xcd_barrier_complete(unsigned* bar, unsigned x, unsigned& nloc, unsigned& nx) {
    const unsigned G = gridDim.x * gridDim.y * gridDim.z;
    unsigned sum, cnt, mine, sp = 0u;
    for (;;) {
        sum = 0u; cnt = 0u; mine = 0u;
#pragma unroll
        for (unsigned j = 0; j < 16; ++j) { const unsigned c = xb_ld(&bar[XB_XCNT(j)]); sum += c; cnt += (c > 0u) ? 1u : 0u; mine = (j == x) ? c : mine; }
        if (sum == G) break;
        __builtin_amdgcn_s_sleep(1);
        if ((++sp & 255u) == 0u) { if (xb_ld(&bar[XB_TMO])) break; if (sp > XB_SPIN_CAP) { atomicAdd(&bar[XB_TMO], 1u); break; } }
    }
    nloc = mine > 0u ? mine : 1u; nx = cnt > 0u ? cnt : 1u;
}

__device__ __forceinline__ void xcd_barrier(const XcdBarrier& b) {
    asm volatile("s_waitcnt vmcnt(0)" ::: "memory");
    __syncthreads();
    if (threadIdx.x == 0) {
        unsigned* bar = b.bar;
        __builtin_amdgcn_s_waitcnt(0);
        unsigned nloc = b.st[0], nx = b.st[1];
        if (nloc == 0u) { xcd_barrier_complete(bar, b.x, nloc, nx); b.st[0] = nloc; b.st[1] = nx; }
        const unsigned old = xb_add(&bar[XB_XSUB(b.x)], 1u);
        const unsigned gen = old / nloc;
        if (old + 1u == (gen + 1u) * nloc) {
            __builtin_amdgcn_fence(__ATOMIC_RELEASE, "agent");
            asm volatile("s_waitcnt vmcnt(0)" ::: "memory");
            const unsigned og = xb_add(&bar[XB_TOP], 1u);
            const unsigned tg = og / nx;
            if (og + 1u == (tg + 1u) * nx) xb_add(&bar[XB_TOPGEN], 1u);
            else XB_SPIN(xb_ld(&bar[XB_TOPGEN]) == tg, bar);
            __builtin_amdgcn_fence(__ATOMIC_ACQUIRE, "agent");
            xb_add(&bar[XB_XGEN(b.x)], 1u);
            asm volatile("s_waitcnt vmcnt(0)" ::: "memory");
        } else {
            XB_SPIN(xb_ld(&bar[XB_XGEN(b.x)]) == gen, bar);
            __builtin_amdgcn_fence(__ATOMIC_ACQUIRE, "agent");
            asm volatile("s_waitcnt vmcnt(0)" ::: "memory");
        }
    }
    __syncthreads();
}
#define IN(i) ldin(a, i)
__global__ void __launch_bounds__(NTHR, 2) mega_fwd(Args a) {
    extern __shared__ __attribute__((aligned(16))) unsigned char lds_raw[];
    LAS unsigned char* lds = (LAS unsigned char*)lds_raw;
    cg::grid_group grid = cg::this_grid();
    const int tid = threadIdx.x, lane0 = tid & 63, wave0 = __builtin_amdgcn_readfirstlane(tid >> 6);
    const int G = gridDim.x, bx = blockIdx.x;
    const int vcu = (G % 8 == 0) ? (bx % 8) * (G / 8) + bx / 8 : bx;
    const int gw0 = vcu * NWAVES + wave0, NGW = G * NWAVES, gtid0 = vcu * NTHR + tid, NT = G * NTHR;
    unsigned char* ws = a.ws;
    bf16* XB = (bf16*)(ws + WS_XB); bf16* PROJ = (bf16*)(ws + WS_PROJ); bf16* VT = (bf16*)(ws + WS_VT); bf16* YA = (bf16*)(ws + WS_YA); bf16* YC = (bf16*)(ws + WS_YC);
    bf16* MG = (bf16*)(ws + WS_MG); bf16* HB = (bf16*)(ws + WS_H); bf16* GB = (bf16*)(ws + WS_G);
    int ph = 0;
    volatile LAS unsigned* bst = (volatile LAS unsigned*)(lds + 131072 + 64);
    if (tid < 2) bst[tid] = 0u;
    __syncthreads();
    XcdBarrier xbar = xcd_barrier_post((unsigned*)(ws + WS_BAR), bst);
#define SEAM() do { xcd_barrier(xbar); } while (0)
#define IDST idptr(ws, 0)
#define ONES idptr(ws, 2 * MC)
#define ZEROS idptr(ws, 2 * MC + DM)
#define STATS(ll, sub) ((float*)(ws + WS_ST) + (size_t)((chunk * NLAYER + (ll)) * 2 + (sub)) * MC * 2)

    prologue_weights(a, lds, gw0, NGW, wave0, lane0);
    convert_rows(IN(0), XB, MC, vcu, NGW);
    { float* idp = (float*)(ws + WS_ID);
      for (int i = gtid0; i < MC; i += NT) { idp[2 * i] = 0.f; idp[2 * i + 1] = 1024.0f * (1.0f - 1e-5f); }
      for (int i = gtid0; i < DM; i += NT) { idp[2 * MC + i] = 1.f; idp[2 * MC + DM + i] = 0.f; } }
    grid.sync();

    for (int chunk = 0; chunk < NCHUNK; ++chunk) {
        const float* xin = (chunk == 0) ? IN(0) : IN(1) + (size_t)(chunk - 1) * MC * DM;
        float* outc = a.out + (size_t)chunk * MC * DM;
        const int T = (chunk == 0) ? 8192 : 2048;
        for (int l = 0; l < NLAYER; ++l) {
            const bf16* wl = (const bf16*)(ws + WS_W) + (size_t)l * W_LAYER;
            const float* csl = (const float*)(ws + WS_CS) + (size_t)l * CS_LAYER;
            { pg8::Gemm g{XB, wl + OFF_WIN, MC, PW, DM, DM, DM}; pg8::StaticOrder S; S.init(MC, PW, G, bx);
              pg8::EpiLN E{PROJ, PW, csl + CS_IN, csl + BC_IN, 4, 512, l > 0 ? STATS(l - 1, 1) : IDST};
              pg8::gemm_phase<pg8::EpiLN, pg8::StaticOrder, true, true>(lds, g, S, E); }
            { pg8::Gemm g{wl + OFF_WV, XB, AW, MC, DM, DM, DM}; pg8::StaticOrder S; S.init(AW, MC, G, bx);
              pg8::EpiLNT E{VT, MC, csl + CS_IN + 1024, csl + BC_IN + 1024, l > 0 ? STATS(l - 1, 1) : IDST};
              pg8::gemm_phase<pg8::EpiLNT, pg8::StaticOrder, true, true>(lds, g, S, E); }
            SEAM();
            attn_phase(PROJ, VT, YA, IN(4) + (size_t)l * 8 * 15 * 31, T, vcu, G, lds);
            convbranch_phase(PROJ, YC, IN(5) + (size_t)l * 3 * AW, IN(6) + (size_t)l * AW, T, vcu, NT);
            SEAM();
            { pg8::Gemm g{YA, wl + OFF_WA, MC, DM, AW, AW, AW, YC, wl + OFF_WC}; pg8::PairedOrder S; S.init(MC, DM, G, bx);
              pg8::EpiGateDual E{MG, DM, PROJ + C_GA, PROJ + C_GCC, PW};
              pg8::gemm_phase<pg8::EpiGateDual, pg8::PairedOrder, true, true>(lds, g, S, E); }
            SEAM();
            { pg8::Gemm g{MG, wl + OFF_WO, MC, DM, DM, DM, DM}; pg8::StaticOrder S; S.init(MC, DM, G, bx);
              pg8::EpiRes2 E{(l == 0) ? xin : outc, outc, XB, DM, IN(10) + (size_t)l * DM, l > 0 ? STATS(l - 1, 1) : IDST,
                             l > 0 ? IN(19) + (size_t)(l - 1) * DM : ONES, l > 0 ? IN(20) + (size_t)(l - 1) * DM : ZEROS, STATS(l, 0)};
              pg8::gemm_phase<pg8::EpiRes2, pg8::StaticOrder, true, true>(lds, g, S, E); }
            SEAM();
            { pg8::Gemm g{XB, wl + OFF_WUP, MC, NUP, DM, DM, DM}; pg8::StaticOrder S; S.init(MC, NUP, G, bx);
              pg8::EpiLN E{HB, NUP, csl + CS_UP, csl + BC_UP, 1 << 30, 0, STATS(l, 0)};
              pg8::gemm_phase<pg8::EpiLN, pg8::StaticOrder, true, true>(lds, g, S, E); }
            SEAM();
            ffnconv_phase(HB, GB, IN(15) + (size_t)l * 3 * NUP, IN(16) + (size_t)l * NUP, T, vcu, NT);
            if (l + 1 == NLAYER && chunk + 1 < NCHUNK) convert_rows(IN(1) + (size_t)chunk * MC * DM, XB, MC, vcu, NGW);
            SEAM();
            { pg8::Gemm g{GB, wl + OFF_WDN, MC, DM, DFF, DFF, DFF}; pg8::StaticOrder S; S.init(MC, DM, G, bx);
              pg8::EpiRes2 E{outc, outc, (l + 1 < NLAYER) ? XB : nullptr, DM, IN(18) + (size_t)l * DM, STATS(l, 0), IN(11) + (size_t)l * DM, IN(12) + (size_t)l * DM, STATS(l, 1)};
              pg8::gemm_phase<pg8::EpiRes2, pg8::StaticOrder, true, true>(lds, g, S, E); }
            SEAM();
            if (l + 1 == NLAYER) {
                ln_rows(outc, XB, IN(19) + (size_t)l * DM, IN(20) + (size_t)l * DM, MC, vcu, NGW, false);
            }
        }
    }
    (void)ph;
}

extern "C" void kernel_launch(void* const* d_in, const int* in_sizes, int n_in, void* d_out, int out_size, void* d_ws, size_t ws_size, hipStream_t stream) {
    static int grid = 0;
    if (grid == 0) {
        if (n_in != 21 || out_size != NCHUNK * MC * DM || ws_size < WS_END) { fprintf(stderr, "kernel_launch: unexpected shapes: n_in %d out %d ws %zu\n", n_in, out_size, ws_size); grid = -1; return; }
        int dev = 0, cus = 0, per_cu = 0;
        if (hipGetDevice(&dev) != hipSuccess || hipDeviceGetAttribute(&cus, hipDeviceAttributeMultiprocessorCount, dev) != hipSuccess) { grid = -1; return; }
        if (hipFuncSetAttribute((const void*)mega_fwd, hipFuncAttributeMaxDynamicSharedMemorySize, LDS_BYTES) != hipSuccess) { fprintf(stderr, "kernel_launch: hipFuncSetAttribute failed\n"); grid = -1; return; }
        if (hipOccupancyMaxActiveBlocksPerMultiprocessor(&per_cu, (const void*)mega_fwd, NTHR, LDS_BYTES) != hipSuccess || per_cu < 1) { fprintf(stderr, "kernel_launch: occupancy query says %d\n", per_cu); per_cu = 1; }
        (void)hipGetLastError();
        grid = cus;
    }
    if (grid < 0) return;
    if (hipMemsetAsync((char*)d_ws + WS_ZERO, 0, ZERO_BYTES, stream) != hipSuccess) { fprintf(stderr, "kernel_launch: memset failed\n"); return; }
    Args a{};
    for (int i = 0; i < 21; ++i) a.in[i] = (const float*)d_in[i];
    a.out = (float*)d_out; a.ws = (unsigned char*)d_ws; a.ph_lo = 0; a.ph_hi = 0;
    void* args[] = {&a};
    hipError_t e = hipLaunchCooperativeKernel((const void*)mega_fwd, dim3(grid), dim3(NTHR), args, LDS_BYTES, stream);
    if (e != hipSuccess) fprintf(stderr, "kernel_launch: cooperative launch failed: %s (grid %d)\n", hipGetErrorString(e), grid);
}
```

```cpp
#include <hip/hip_runtime.h>
#include <hip/hip_cooperative_groups.h>
#include <cstdio>
#include <cstdint>
namespace cg = cooperative_groups;
namespace pg8 {
#define PG8_LAS __attribute__((address_space(3)))
typedef unsigned short bf16_t;
typedef short bf16x8 __attribute__((ext_vector_type(8)));
typedef float f32x4 __attribute__((ext_vector_type(4)));
typedef unsigned u32x4 __attribute__((ext_vector_type(4)));
constexpr int BM = 256, BK = 64, HALF = 128, HTB = HALF * BK * 2  , STAGE_BYTES = 8 * HTB, NXCD = 8, WGM = 8;

__host__ __device__ __forceinline__ int lds_byte(int r, int c) { const int st = (r >> 4) * 2 + (c >> 5), rr = r & 15, cc = c & 31, ob = rr * 64 + cc * 2; return st * 1024 + (ob ^ (((ob >> 9) & 1) << 5)); }
__host__ __device__ __forceinline__ void stage_rc(int b, int& R, int& C) { const int st = b / 1024, sb = b % 1024, swz = sb ^ (((sb >> 9) & 1) << 5); R = (st >> 1) * 16 + swz / 64; C = (st & 1) * 32 + (swz % 64) / 2; }
__host__ __device__ __forceinline__ int perm32(int rho) { const int n = rho >> 4, i = rho & 15; return 8 * (i >> 2) + 4 * n + (i & 3); }

struct Unit { int pm, pn, part; };
struct Gemm { const bf16_t* A; const bf16_t* Bt; int M, N, K, lda, ldb; const bf16_t* A2; const bf16_t* Bt2; };

struct StaticOrder {
    int nM, nN, nwg, G, c;
    __host__ __device__ void init(int M, int N, int G_, int c_) { nM = M / BM; nN = N / BM; nwg = nM * nN; G = G_; c = c_; }
    __host__ __device__ bool next(int i, Unit& u) const {
        const long L = (long)i * G + c; if (L >= nwg) return false;
        int wgid = (int)L; { const int q = nwg / NXCD, r = nwg % NXCD, xcd = wgid % NXCD, off = wgid / NXCD; wgid = (xcd < r ? xcd * (q + 1) : r * (q + 1) + (xcd - r) * q) + off; }
        const int nig = WGM * nN, gid = wgid / nig, fm = gid * WGM, gsz = (nM - fm) < WGM ? (nM - fm) : WGM;
        u.pm = fm + ((wgid % nig) % gsz); u.pn = (wgid % nig) / gsz; u.part = 0; return true;
    }
    __device__ __forceinline__ void a_ready(const Unit&) const {}
    __device__ __forceinline__ void done(const Unit&) const {}
};

__device__ __forceinline__ unsigned cvt_pk_bf16(float lo, float hi) { unsigned r; asm volatile("v_cvt_pk_bf16_f32 %0, %1, %2" : "=v"(r) : "v"(lo), "v"(hi)); return r; }
typedef float f32x2 __attribute__((ext_vector_type(2)));
template <class Epi, class Sched, bool ALIGN_EPI = false, bool SP2 = false>
__device__ __forceinline__ void gemm_phase(PG8_LAS unsigned char* lds, const Gemm g, const Sched& S, const Epi& E) {
    int tid_ = threadIdx.x; asm volatile("" : "+v"(tid_));
    const int tid = tid_, wid = __builtin_amdgcn_readfirstlane(tid >> 6), lane = tid & 63, wr = wid >> 2, wc = wid & 3, fr = lane & 15, fq = lane >> 4;
    const int K = g.K, nt = K / BK;
    unsigned voffA[2], voffB[2];
#pragma unroll
    for (int i = 0; i < 2; ++i) { int R, C; stage_rc(tid * 16 + i * 8192, R, C); const int Rb = Epi::PERM ? ((R & ~31) + perm32(R & 31)) : R;
        voffA[i] = (unsigned)(R * g.lda + C) * 2u; voffB[i] = (unsigned)(Rb * g.ldb + C) * 2u; }
    const size_t kstep = (size_t)(BK * 2);
    const size_t hstepA = (size_t)HALF * g.lda * 2, hstepB = (size_t)HALF * g.ldb * 2;
    const size_t tstepA = 2 * hstepA, tstepB = 2 * hstepB;
    const unsigned ldsw = (unsigned)wid * 1024u;
    const int aoff = lds_byte(wr * 64 + fr, fq * 8), boff = lds_byte(wc * 32 + fr, fq * 8);
#define PG8_SA(b, h) (((b) * 2 + (h)) * HTB)
#define PG8_SB(b, h) ((4 + (b) * 2 + (h)) * HTB)
#define PG8_STAGE(bufoff, gbase, voff) do { _Pragma("unroll") for (int _i = 0; _i < 2; ++_i) \
        __builtin_amdgcn_global_load_lds((const unsigned*)((const char*)(gbase) + (voff)[_i]), (PG8_LAS unsigned*)(lds + (bufoff) + ldsw + _i * 8192), 16, 0, 0); } while (0)
#define PG8_LDA(dst, b, h) do { _Pragma("unroll") for (int m = 0; m < 4; ++m) _Pragma("unroll") for (int k = 0; k < 2; ++k) dst[m][k] = *(const PG8_LAS bf16x8*)(lds + PG8_SA(b, h) + aoff + m * 2048 + k * 1024); } while (0)
#define PG8_LDB(dst, b, h) do { _Pragma("unroll") for (int n = 0; n < 2; ++n) _Pragma("unroll") for (int k = 0; k < 2; ++k) dst[n][k] = *(const PG8_LAS bf16x8*)(lds + PG8_SB(b, h) + boff + n * 2048 + k * 1024); } while (0)
#define PG8_MMA(ai, bj, At, Bt) do { __builtin_amdgcn_s_setprio(1); _Pragma("unroll") for (int m = 0; m < 4; ++m) _Pragma("unroll") for (int n = 0; n < 2; ++n) _Pragma("unroll") for (int k = 0; k < 2; ++k) \
        acc[ai][bj][m][n] = __builtin_amdgcn_mfma_f32_16x16x32_bf16(Bt[n][k], At[m][k], acc[ai][bj][m][n], 0, 0, 0); __builtin_amdgcn_s_setprio(0); } while (0)
#define PG8_WAIT_V(n) asm volatile("s_waitcnt vmcnt(" #n ")" ::: "memory")
#define PG8_WAIT_L(n) asm volatile("s_waitcnt lgkmcnt(" #n ")" ::: "memory")
#define PG8_BAR __builtin_amdgcn_s_barrier()
#define PG8_SCHED __builtin_amdgcn_sched_barrier(0)
    Unit cur, nxt; int ui = 0;
    if (!S.next(0, cur)) return;
    f32x4 acc[2][2][4][2];
#pragma unroll
    for (int a = 0; a < 2; ++a)
#pragma unroll
        for (int b = 0; b < 2; ++b)
#pragma unroll
            for (int m = 0; m < 4; ++m)
#pragma unroll
                for (int n = 0; n < 2; ++n) acc[a][b][m][n] = (f32x4){0.f, 0.f, 0.f, 0.f};
    bf16x8 At[4][2], B0[2][2], B1[2][2];
    const char* cA = (const char*)((Epi::DUAL && cur.part) ? g.A2 : g.A) + (size_t)cur.pm * tstepA; const char* cB = (const char*)((Epi::DUAL && cur.part) ? g.Bt2 : g.Bt) + (size_t)cur.pn * tstepB;
    S.a_ready(cur);
    if constexpr (SP2) {
        PG8_STAGE(PG8_SB(0, 0), cB, voffB); PG8_STAGE(PG8_SB(0, 1), cB + hstepB, voffB); PG8_STAGE(PG8_SA(0, 0), cA, voffA); PG8_STAGE(PG8_SA(0, 1), cA + hstepA, voffA);
        if (wr == 1) PG8_BAR;
        PG8_WAIT_V(2); PG8_BAR;
        PG8_STAGE(PG8_SB(1, 0), cB + kstep, voffB); PG8_STAGE(PG8_SA(1, 0), cA + kstep, voffA); PG8_STAGE(PG8_SB(1, 1), cB + hstepB + kstep, voffB);
        PG8_WAIT_V(6); PG8_BAR;
    } else {
        PG8_STAGE(PG8_SB(0, 0), cB, voffB); PG8_STAGE(PG8_SA(0, 0), cA, voffA); PG8_STAGE(PG8_SB(0, 1), cB + hstepB, voffB); PG8_STAGE(PG8_SA(0, 1), cA + hstepA, voffA);
        if (wr == 1) PG8_BAR;
        PG8_WAIT_V(4); PG8_BAR;
        PG8_STAGE(PG8_SB(1, 0), cB + kstep, voffB); PG8_STAGE(PG8_SA(1, 0), cA + kstep, voffA); PG8_STAGE(PG8_SB(1, 1), cB + hstepB + kstep, voffB);
        PG8_WAIT_V(6); PG8_BAR;
    }
    for (;;) {
        const bool has_next = S.next(ui + 1, nxt);
        const char* nA = has_next ? (const char*)((Epi::DUAL && nxt.part) ? g.A2 : g.A) + (size_t)nxt.pm * tstepA : cA; const char* nB = has_next ? (const char*)((Epi::DUAL && nxt.part) ? g.Bt2 : g.Bt) + (size_t)nxt.pn * tstepB : cB;
        for (int t = 0; t < nt; t += 2) {
            const bool last = (t == nt - 2);
            const char* a1 = cA + (size_t)(t + 1) * kstep;
            const char* a2 = last ? nA : cA + (size_t)(t + 2) * kstep; const char* b2 = last ? nB : cB + (size_t)(t + 2) * kstep;
            const char* a3 = a2 + kstep; const char* b3 = b2 + kstep;
            if (last && has_next) S.a_ready(nxt);
            if constexpr (SP2) {
            PG8_LDB(B0, 0, 0); PG8_LDB(B1, 0, 1); PG8_SCHED; PG8_LDA(At, 0, 0); PG8_STAGE(PG8_SA(1, 1), a1 + hstepA, voffA);
            PG8_WAIT_V(8); PG8_WAIT_L(0); PG8_BAR; PG8_MMA(0, 0, At, B0); PG8_MMA(0, 1, At, B1); PG8_BAR; PG8_SCHED;
            PG8_LDA(At, 0, 1); PG8_STAGE(PG8_SB(0, 0), b2, voffB); PG8_STAGE(PG8_SB(0, 1), b2 + hstepB, voffB); PG8_STAGE(PG8_SA(0, 0), a2, voffA);
            PG8_WAIT_V(8); PG8_WAIT_L(0); PG8_BAR; PG8_MMA(1, 0, At, B0); PG8_MMA(1, 1, At, B1); PG8_BAR; PG8_SCHED;
            PG8_LDB(B0, 1, 0); PG8_LDB(B1, 1, 1); PG8_SCHED; PG8_LDA(At, 1, 0); PG8_STAGE(PG8_SA(0, 1), a2 + hstepA, voffA);
            PG8_WAIT_V(8); PG8_WAIT_L(0); PG8_BAR; PG8_MMA(0, 0, At, B0); PG8_MMA(0, 1, At, B1); PG8_BAR; PG8_SCHED;
            PG8_LDA(At, 1, 1); PG8_STAGE(PG8_SB(1, 0), b3, voffB); PG8_STAGE(PG8_SB(1, 1), b3 + hstepB, voffB); PG8_STAGE(PG8_SA(1, 0), a3, voffA);
            PG8_WAIT_V(8); PG8_WAIT_L(0); PG8_BAR; PG8_MMA(1, 0, At, B0); PG8_MMA(1, 1, At, B1); PG8_BAR; PG8_SCHED;
            } else {
            PG8_LDB(B0, 0, 0); PG8_SCHED; PG8_LDA(At, 0, 0); PG8_STAGE(PG8_SA(1, 1), a1 + hstepA, voffA);
            PG8_WAIT_L(8); PG8_BAR; PG8_WAIT_L(0); PG8_MMA(0, 0, At, B0); PG8_BAR; PG8_SCHED;
            PG8_LDB(B1, 0, 1); PG8_STAGE(PG8_SB(0, 0), b2, voffB);
            PG8_BAR; PG8_WAIT_L(0); PG8_MMA(0, 1, At, B1); PG8_BAR;
            PG8_LDA(At, 0, 1); PG8_STAGE(PG8_SA(0, 0), a2, voffA);
            PG8_BAR; PG8_WAIT_L(0); PG8_MMA(1, 0, At, B0); PG8_BAR; PG8_SCHED;
            PG8_STAGE(PG8_SB(0, 1), b2 + hstepB, voffB);
            PG8_WAIT_V(6); PG8_BAR; PG8_MMA(1, 1, At, B1); PG8_BAR;
            PG8_LDB(B0, 1, 0); PG8_SCHED; PG8_LDA(At, 1, 0); PG8_STAGE(PG8_SA(0, 1), a2 + hstepA, voffA);
            PG8_WAIT_L(8); PG8_BAR; PG8_WAIT_L(0); PG8_MMA(0, 0, At, B0); PG8_BAR; PG8_SCHED;
            PG8_LDB(B1, 1, 1); PG8_STAGE(PG8_SB(1, 0), b3, voffB);
            PG8_BAR; PG8_WAIT_L(0); PG8_MMA(0, 1, At, B1); PG8_BAR;
            PG8_LDA(At, 1, 1); PG8_STAGE(PG8_SA(1, 0), a3, voffA);
            PG8_BAR; PG8_WAIT_L(0); PG8_MMA(1, 0, At, B0); PG8_BAR; PG8_SCHED;
            PG8_STAGE(PG8_SB(1, 1), b3 + hstepB, voffB);
            PG8_WAIT_V(6); PG8_BAR; PG8_MMA(1, 1, At, B1); PG8_BAR;
            }
        }
        if constexpr (ALIGN_EPI) { if (wr == 0) PG8_BAR; }
        bool keep_acc_ = false;
        if constexpr (Epi::DUAL) { if (cur.part == 0) { E.mid(acc, cur, wr, wc, fr, fq); keep_acc_ = true; } else { E(acc, cur, wr, wc, fr, fq); } S.done(cur); }
        else if constexpr (!Epi::AFTER_DRAIN) { E(acc, cur, wr, wc, fr, fq); S.done(cur); }
        if (!has_next) break;
        if (!keep_acc_)
#pragma unroll
        for (int a = 0; a < 2; ++a)
#pragma unroll
            for (int b = 0; b < 2; ++b)
#pragma unroll
                for (int m = 0; m < 4; ++m)
#pragma unroll
                    for (int n = 0; n < 2; ++n) acc[a][b][m][n] = (f32x4){0.f, 0.f, 0.f, 0.f};
        cur = nxt; cA = nA; cB = nB; ++ui;
        if constexpr (ALIGN_EPI) { if (wr == 1) PG8_BAR; }
    }
    PG8_WAIT_V(0);
    if constexpr (!ALIGN_EPI) { if (wr == 0) PG8_BAR; }
    PG8_BAR;
    if constexpr (Epi::AFTER_DRAIN) { E.fused(acc, cur, wr, wc, fr, fq, lds, wid, lane); S.done(cur); }
#undef PG8_SA
#undef PG8_SB
#undef PG8_STAGE
#undef PG8_LDA
#undef PG8_LDB
#undef PG8_MMA
#undef PG8_WAIT_V
#undef PG8_WAIT_L
#undef PG8_BAR
#undef PG8_SCHED
}
}
namespace pg8 {
typedef unsigned u32x2 __attribute__((ext_vector_type(2)));
__device__ __forceinline__ float bf_lo(unsigned w) { return __builtin_bit_cast(float, w << 16); }
__device__ __forceinline__ float bf_hi(unsigned w) { return __builtin_bit_cast(float, w & 0xffff0000u); }
__device__ __forceinline__ float sigmoidf_fast(float x) { return __builtin_amdgcn_rcpf(1.0f + __builtin_amdgcn_exp2f(-1.4426950408889634f * x)); }
template <int MODE> struct EpiB {
    static constexpr bool DUAL = false; static constexpr bool PERM = true, AFTER_DRAIN = false;
    bf16_t* O; int ldc; const float* bias; int bias_skip_tile, bias_skip; const bf16_t* gate; int ldg;
    __device__ __forceinline__ void operator()(const f32x4 (&acc)[2][2][4][2], const Unit& u, int wr, int wc, int fr, int fq) const {
        const int row0 = u.pm * BM + wr * 64 + fr; const int col0 = u.pn * BM + wc * 32 + 8 * fq;
        f32x4 bv[2][2];
        if (MODE == 0) { const int bcol0 = col0 + (u.pn >= bias_skip_tile ? bias_skip : 0);
#pragma unroll
            for (int bj = 0; bj < 2; ++bj)
#pragma unroll
                for (int n = 0; n < 2; ++n) bv[bj][n] = *(const f32x4*)(bias + bcol0 + bj * HALF + 4 * n); }
#pragma unroll
        for (int ai = 0; ai < 2; ++ai)
#pragma unroll
            for (int m = 0; m < 4; ++m) { const int row = row0 + ai * HALF + m * 16; bf16_t* rowp = O + (size_t)row * ldc + col0;
                float rb = 0.f; if (MODE == 1) rb = bias[row];
#pragma unroll
                for (int bj = 0; bj < 2; ++bj) { f32x4 v0 = acc[ai][bj][m][0], v1 = acc[ai][bj][m][1];
                    if (MODE == 0) { v0 = v0 + bv[bj][0]; v1 = v1 + bv[bj][1]; }
                    if (MODE == 1) { v0 = v0 + rb; v1 = v1 + rb; }
                    if (MODE == 2 || MODE == 3) { const u32x4 gw = *(const u32x4*)(gate + (size_t)row * ldg + col0 + bj * HALF);
                        v0[0] *= sigmoidf_fast(bf_lo(gw.x)); v0[1] *= sigmoidf_fast(bf_hi(gw.x)); v0[2] *= sigmoidf_fast(bf_lo(gw.y)); v0[3] *= sigmoidf_fast(bf_hi(gw.y));
                        v1[0] *= sigmoidf_fast(bf_lo(gw.z)); v1[1] *= sigmoidf_fast(bf_hi(gw.z)); v1[2] *= sigmoidf_fast(bf_lo(gw.w)); v1[3] *= sigmoidf_fast(bf_hi(gw.w)); }
                    if (MODE == 3) { const u32x4 pw = *(const u32x4*)(rowp + bj * HALF);
                        v0[0] += bf_lo(pw.x); v0[1] += bf_hi(pw.x); v0[2] += bf_lo(pw.y); v0[3] += bf_hi(pw.y);
                        v1[0] += bf_lo(pw.z); v1[1] += bf_hi(pw.z); v1[2] += bf_lo(pw.w); v1[3] += bf_hi(pw.w); }
                    u32x4 w; w.x = cvt_pk_bf16(v0[0], v0[1]); w.y = cvt_pk_bf16(v0[2], v0[3]); w.z = cvt_pk_bf16(v1[0], v1[1]); w.w = cvt_pk_bf16(v1[2], v1[3]);
                    *(u32x4*)(rowp + bj * HALF) = w; } }
    }
};
template <bool ACCUM> struct EpiGate {
    static constexpr bool DUAL = false; static constexpr bool PERM = true, AFTER_DRAIN = false;
    bf16_t* O; int ldc; const bf16_t* gate; int ldg;
    __device__ __forceinline__ void operator()(const f32x4 (&acc)[2][2][4][2], const Unit& u, int wr, int wc, int fr, int fq) const {
        const int row0 = u.pm * BM + wr * 64 + fr; const int col0 = u.pn * BM + wc * 32 + 8 * fq;
        u32x4 gw[3][2], pw[3][2];
#define EG_LOAD(gg) do { const int rw_ = row0 + ((gg) >> 2) * HALF + ((gg) & 3) * 16; \
            _Pragma("unroll") for (int bj = 0; bj < 2; ++bj) { gw[(gg) % 3][bj] = *(const u32x4*)(gate + (size_t)rw_ * ldg + col0 + bj * HALF); if (ACCUM) pw[(gg) % 3][bj] = *(const u32x4*)(O + (size_t)rw_ * ldc + col0 + bj * HALF); } } while (0)
        EG_LOAD(0); EG_LOAD(1);
#pragma unroll
        for (int g = 0; g < 8; ++g) { const int ai = g >> 2, m = g & 3; const int row = row0 + ai * HALF + m * 16; bf16_t* rowp = O + (size_t)row * ldc + col0;
            if (g + 2 < 8) EG_LOAD(g + 2);
#pragma unroll
            for (int bj = 0; bj < 2; ++bj) { f32x4 v0 = acc[ai][bj][m][0], v1 = acc[ai][bj][m][1]; const u32x4 q = gw[g % 3][bj];
                v0[0] *= sigmoidf_fast(bf_lo(q.x)); v0[1] *= sigmoidf_fast(bf_hi(q.x)); v0[2] *= sigmoidf_fast(bf_lo(q.y)); v0[3] *= sigmoidf_fast(bf_hi(q.y));
                v1[0] *= sigmoidf_fast(bf_lo(q.z)); v1[1] *= sigmoidf_fast(bf_hi(q.z)); v1[2] *= sigmoidf_fast(bf_lo(q.w)); v1[3] *= sigmoidf_fast(bf_hi(q.w));
                if (ACCUM) { const u32x4 p = pw[g % 3][bj];
                    v0[0] += bf_lo(p.x); v0[1] += bf_hi(p.x); v0[2] += bf_lo(p.y); v0[3] += bf_hi(p.y); v1[0] += bf_lo(p.z); v1[1] += bf_hi(p.z); v1[2] += bf_lo(p.w); v1[3] += bf_hi(p.w); }
                u32x4 w; w.x = cvt_pk_bf16(v0[0], v0[1]); w.y = cvt_pk_bf16(v0[2], v0[3]); w.z = cvt_pk_bf16(v1[0], v1[1]); w.w = cvt_pk_bf16(v1[2], v1[3]);
                *(u32x4*)(rowp + bj * HALF) = w; } }
#undef EG_LOAD
    }
};
struct EpiGateDual {
    static constexpr bool DUAL = true; static constexpr bool PERM = true, AFTER_DRAIN = false;
    bf16_t* O; int ldc; const bf16_t* ga; const bf16_t* gc; int ldg;
    static __device__ __forceinline__ float em(float x) { return __builtin_amdgcn_exp2f(-1.4426950408889634f * x); }
    __device__ __forceinline__ void mid(f32x4 (&acc)[2][2][4][2], const Unit& u, int wr, int wc, int fr, int fq) const {
        const int row0 = u.pm * BM + wr * 64 + fr; const int col0 = u.pn * BM + wc * 32 + 8 * fq;
        u32x4 qa[3][2], qc[3][2];
#define EGD_LOAD(gg) do { const int rw_ = row0 + ((gg) >> 2) * HALF + ((gg) & 3) * 16; \
            _Pragma("unroll") for (int bj = 0; bj < 2; ++bj) { qa[(gg) % 3][bj] = *(const u32x4*)(ga + (size_t)rw_ * ldg + col0 + bj * HALF); qc[(gg) % 3][bj] = *(const u32x4*)(gc + (size_t)rw_ * ldg + col0 + bj * HALF); } } while (0)
        EGD_LOAD(0); EGD_LOAD(1);
#pragma unroll
        for (int g = 0; g < 8; ++g) { const int ai = g >> 2, m = g & 3;
            if (g + 2 < 8) EGD_LOAD(g + 2);
#pragma unroll
            for (int bj = 0; bj < 2; ++bj) { const u32x4 a = qa[g % 3][bj], c = qc[g % 3][bj];
#define EGD_R(av, cv) ((1.0f + em(cv)) * __builtin_amdgcn_rcpf(1.0f + em(av)))
                acc[ai][bj][m][0][0] *= EGD_R(bf_lo(a.x), bf_lo(c.x)); acc[ai][bj][m][0][1] *= EGD_R(bf_hi(a.x), bf_hi(c.x)); acc[ai][bj][m][0][2] *= EGD_R(bf_lo(a.y), bf_lo(c.y)); acc[ai][bj][m][0][3] *= EGD_R(bf_hi(a.y), bf_hi(c.y));
                acc[ai][bj][m][1][0] *= EGD_R(bf_lo(a.z), bf_lo(c.z)); acc[ai][bj][m][1][1] *= EGD_R(bf_hi(a.z), bf_hi(c.z)); acc[ai][bj][m][1][2] *= EGD_R(bf_lo(a.w), bf_lo(c.w)); acc[ai][bj][m][1][3] *= EGD_R(bf_hi(a.w), bf_hi(c.w));
#undef EGD_R
            } }
#undef EGD_LOAD
    }
    __device__ __forceinline__ void operator()(const f32x4 (&acc)[2][2][4][2], const Unit& u, int wr, int wc, int fr, int fq) const {
        const int row0 = u.pm * BM + wr * 64 + fr; const int col0 = u.pn * BM + wc * 32 + 8 * fq;
        u32x4 qc[3][2];
#define EGD_LOAD(gg) do { const int rw_ = row0 + ((gg) >> 2) * HALF + ((gg) & 3) * 16; \
            _Pragma("unroll") for (int bj = 0; bj < 2; ++bj) qc[(gg) % 3][bj] = *(const u32x4*)(gc + (size_t)rw_ * ldg + col0 + bj * HALF); } while (0)
        EGD_LOAD(0); EGD_LOAD(1);
#pragma unroll
        for (int g = 0; g < 8; ++g) { const int ai = g >> 2, m = g & 3; const int row = row0 + ai * HALF + m * 16; bf16_t* rowp = O + (size_t)row * ldc + col0;
            if (g + 2 < 8) EGD_LOAD(g + 2);
#pragma unroll
            for (int bj = 0; bj < 2; ++bj) { f32x4 v0 = acc[ai][bj][m][0], v1 = acc[ai][bj][m][1]; const u32x4 q = qc[g % 3][bj];
                v0[0] *= sigmoidf_fast(bf_lo(q.x)); v0[1] *= sigmoidf_fast(bf_hi(q.x)); v0[2] *= sigmoidf_fast(bf_lo(q.y)); v0[3] *= sigmoidf_fast(bf_hi(q.y));
                v1[0] *= sigmoidf_fast(bf_lo(q.z)); v1[1] *= sigmoidf_fast(bf_hi(q.z)); v1[2] *= sigmoidf_fast(bf_lo(q.w)); v1[3] *= sigmoidf_fast(bf_hi(q.w));
                u32x4 w; w.x = cvt_pk_bf16(v0[0], v0[1]); w.y = cvt_pk_bf16(v0[2], v0[3]); w.z = cvt_pk_bf16(v1[0], v1[1]); w.w = cvt_pk_bf16(v1[2], v1[3]);
                *(u32x4*)(rowp + bj * HALF) = w; } }
#undef EGD_LOAD
    }
};
struct PairedOrder {
    StaticOrder so;
    __host__ __device__ void init(int M, int N, int G_, int c_) { so.init(M, N, G_, c_); }
    __host__ __device__ bool next(int i, Unit& u) const { const bool ok = so.next(i >> 1, u); u.part = i & 1; return ok; }
    __device__ __forceinline__ void a_ready(const Unit&) const {}
    __device__ __forceinline__ void done(const Unit&) const {}
};
struct EpiRes {
    static constexpr bool DUAL = false; static constexpr bool PERM = false, AFTER_DRAIN = false;
    const float* base; float* out; int ldc; const float* bias; float alpha;
    __device__ __forceinline__ void operator()(const f32x4 (&acc)[2][2][4][2], const Unit& u, int wr, int wc, int fr, int fq) const {
        const int col0 = u.pn * BM + wc * 32 + 4 * fq;
        f32x4 bv[2][2];
#pragma unroll
        for (int bj = 0; bj < 2; ++bj)
#pragma unroll
            for (int n = 0; n < 2; ++n) bv[bj][n] = *(const f32x4*)(bias + col0 + bj * HALF + n * 16);
#pragma unroll
        for (int ai = 0; ai < 2; ++ai)
#pragma unroll
            for (int m = 0; m < 4; ++m) { const size_t off = (size_t)(u.pm * BM + ai * HALF + wr * 64 + m * 16 + fr) * ldc + col0;
#pragma unroll
                for (int bj = 0; bj < 2; ++bj)
#pragma unroll
                    for (int n = 0; n < 2; ++n) { const f32x4 bs = *(const f32x4*)(base + off + bj * HALF + n * 16);
                        *(f32x4*)(out + off + bj * HALF + n * 16) = bs * alpha + acc[ai][bj][m][n] + bv[bj][n]; } }
    }
};

__device__ __forceinline__ void stats_mr(const f32x2 s, float& mu, float& r) { mu = s.x * (1.0f / 1024.0f); const float var = s.y * (1.0f / 1024.0f) - mu * mu; r = __builtin_amdgcn_rsqf(var + 1e-5f); }
struct EpiLN {
    static constexpr bool DUAL = false; static constexpr bool PERM = true, AFTER_DRAIN = false;
    bf16_t* O; int ldc; const float* cs; const float* bc; int skip_tile, skip; const float* stats;
    __device__ __forceinline__ void operator()(const f32x4 (&acc)[2][2][4][2], const Unit& u, int wr, int wc, int fr, int fq) const {
        const int row0 = u.pm * BM + wr * 64 + fr; const int col0 = u.pn * BM + wc * 32 + 8 * fq; const int bcol0 = col0 + (u.pn >= skip_tile ? skip : 0);
        f32x2 sv[2][4];
#pragma unroll
        for (int ai = 0; ai < 2; ++ai)
#pragma unroll
            for (int m = 0; m < 4; ++m) sv[ai][m] = *(const f32x2*)(stats + 2 * (size_t)(row0 + ai * HALF + m * 16));
        f32x4 cv[2][2], bv[2][2];
#pragma unroll
        for (int bj = 0; bj < 2; ++bj)
#pragma unroll
            for (int n = 0; n < 2; ++n) { cv[bj][n] = *(const f32x4*)(cs + bcol0 + bj * HALF + 4 * n); bv[bj][n] = *(const f32x4*)(bc + bcol0 + bj * HALF + 4 * n); }
#pragma unroll
        for (int ai = 0; ai < 2; ++ai)
#pragma unroll
            for (int m = 0; m < 4; ++m) { const int row = row0 + ai * HALF + m * 16; bf16_t* rowp = O + (size_t)row * ldc + col0;
                float mu, r; stats_mr(sv[ai][m], mu, r);
#pragma unroll
                for (int bj = 0; bj < 2; ++bj) { const f32x4 v0 = (acc[ai][bj][m][0] - cv[bj][0] * mu) * r + bv[bj][0], v1 = (acc[ai][bj][m][1] - cv[bj][1] * mu) * r + bv[bj][1];
                    u32x4 w; w.x = cvt_pk_bf16(v0[0], v0[1]); w.y = cvt_pk_bf16(v0[2], v0[3]); w.z = cvt_pk_bf16(v1[0], v1[1]); w.w = cvt_pk_bf16(v1[2], v1[3]);
                    *(u32x4*)(rowp + bj * HALF) = w; } }
    }
};
struct EpiLNP1 {
    static constexpr bool DUAL = false; static constexpr bool PERM = true, AFTER_DRAIN = false;
    bf16_t* O; int ldc; const float* cs; const float* bc; const float* stats;
    __device__ __forceinline__ void operator()(const f32x4 (&acc)[2][2][4][2], const Unit& u, int wr, int wc, int fr, int fq) const {
        const int row0 = u.pm * BM + wr * 64 + fr; const int lc = wc * 32 + 8 * fq; const int pn = u.pn; const bool pair = (pn >= 4) && (pn < 8);
        int src0, src1, dst0;
        if (pn < 4) { src0 = 256 * pn; src1 = src0 + 128; dst0 = src0; }
        else if (pn < 8) { src0 = 1536 + 128 * (pn - 4); src1 = 2560 + 128 * (pn - 4); dst0 = 1024 + 128 * (pn - 4); }
        else if (pn < 10) { src0 = 2048 + 256 * (pn - 8); src1 = src0 + 128; dst0 = 1536 + 256 * (pn - 8); }
        else { src0 = 256 * pn + 512; src1 = src0 + 128; dst0 = 256 * pn; }
        f32x2 sv[2][4];
#pragma unroll
        for (int ai = 0; ai < 2; ++ai)
#pragma unroll
            for (int m = 0; m < 4; ++m) sv[ai][m] = *(const f32x2*)(stats + 2 * (size_t)(row0 + ai * HALF + m * 16));
        f32x4 cv[2][2], bv[2][2];
#pragma unroll
        for (int n = 0; n < 2; ++n) { cv[0][n] = *(const f32x4*)(cs + src0 + lc + 4 * n); bv[0][n] = *(const f32x4*)(bc + src0 + lc + 4 * n);
            cv[1][n] = *(const f32x4*)(cs + src1 + lc + 4 * n); bv[1][n] = *(const f32x4*)(bc + src1 + lc + 4 * n); }
#pragma unroll
        for (int ai = 0; ai < 2; ++ai)
#pragma unroll
            for (int m = 0; m < 4; ++m) { const int row = row0 + ai * HALF + m * 16; bf16_t* rowp = O + (size_t)row * ldc + dst0 + lc;
                float mu, r; stats_mr(sv[ai][m], mu, r);
                const f32x4 a0 = (acc[ai][0][m][0] - cv[0][0] * mu) * r + bv[0][0], a1 = (acc[ai][0][m][1] - cv[0][1] * mu) * r + bv[0][1];
                const f32x4 b0 = (acc[ai][1][m][0] - cv[1][0] * mu) * r + bv[1][0], b1 = (acc[ai][1][m][1] - cv[1][1] * mu) * r + bv[1][1];
                if (pair) { const f32x4 p0 = a0 * b0, p1 = a1 * b1;
                    u32x4 w; w.x = cvt_pk_bf16(p0[0], p0[1]); w.y = cvt_pk_bf16(p0[2], p0[3]); w.z = cvt_pk_bf16(p1[0], p1[1]); w.w = cvt_pk_bf16(p1[2], p1[3]);
                    *(u32x4*)(rowp) = w; }
                else { u32x4 w; w.x = cvt_pk_bf16(a0[0], a0[1]); w.y = cvt_pk_bf16(a0[2], a0[3]); w.z = cvt_pk_bf16(a1[0], a1[1]); w.w = cvt_pk_bf16(a1[2], a1[3]);
                    *(u32x4*)(rowp) = w;
                    u32x4 x; x.x = cvt_pk_bf16(b0[0], b0[1]); x.y = cvt_pk_bf16(b0[2], b0[3]); x.z = cvt_pk_bf16(b1[0], b1[1]); x.w = cvt_pk_bf16(b1[2], b1[3]);
                    *(u32x4*)(rowp + HALF) = x; } }
    }
};
struct EpiLNT {
    static constexpr bool DUAL = false; static constexpr bool PERM = true, AFTER_DRAIN = false;
    bf16_t* O; int ldc; const float* cs; const float* bc; const float* stats;
    __device__ __forceinline__ void operator()(const f32x4 (&acc)[2][2][4][2], const Unit& u, int wr, int wc, int fr, int fq) const {
        const int row0 = u.pm * BM + wr * 64 + fr; const int col0 = u.pn * BM + wc * 32 + 8 * fq;
        f32x4 sq[2][4]; float cr[2][4], br[2][4];
#pragma unroll
        for (int bj = 0; bj < 2; ++bj)
#pragma unroll
            for (int q = 0; q < 4; ++q) sq[bj][q] = *(const f32x4*)(stats + 2 * (size_t)(col0 + bj * HALF) + 4 * q);
#pragma unroll
        for (int ai = 0; ai < 2; ++ai)
#pragma unroll
            for (int m = 0; m < 4; ++m) { cr[ai][m] = cs[row0 + ai * HALF + m * 16]; br[ai][m] = bc[row0 + ai * HALF + m * 16]; }
        float mu[2][8], r[2][8];
#pragma unroll
        for (int bj = 0; bj < 2; ++bj)
#pragma unroll
            for (int q = 0; q < 4; ++q) { stats_mr((f32x2){sq[bj][q][0], sq[bj][q][1]}, mu[bj][2 * q], r[bj][2 * q]); stats_mr((f32x2){sq[bj][q][2], sq[bj][q][3]}, mu[bj][2 * q + 1], r[bj][2 * q + 1]); }
#pragma unroll
        for (int ai = 0; ai < 2; ++ai)
#pragma unroll
            for (int m = 0; m < 4; ++m) { const int row = row0 + ai * HALF + m * 16; bf16_t* rowp = O + (size_t)row * ldc + col0; const float c = cr[ai][m], b = br[ai][m];
#pragma unroll
                for (int bj = 0; bj < 2; ++bj) { float v[8];
#pragma unroll
                    for (int e = 0; e < 8; ++e) v[e] = (acc[ai][bj][m][e >> 2][e & 3] - c * mu[bj][e]) * r[bj][e] + b;
                    u32x4 w; w.x = cvt_pk_bf16(v[0], v[1]); w.y = cvt_pk_bf16(v[2], v[3]); w.z = cvt_pk_bf16(v[4], v[5]); w.w = cvt_pk_bf16(v[6], v[7]);
                    *(u32x4*)(rowp + bj * HALF) = w; } }
    }
};
struct EpiRes2 {
    static constexpr bool DUAL = false; static constexpr bool PERM = true, AFTER_DRAIN = false;
    const float* base; float* out; bf16_t* zb; int ldc; const float* bias; const float* bstats; const float* bg; const float* bb; float* ostats;
    __device__ __forceinline__ void operator()(const f32x4 (&acc)[2][2][4][2], const Unit& u, int wr, int wc, int fr, int fq) const {
        constexpr float alpha = 1.41421356237309515f;
        const int urow = u.pm * BM + wr * 64, ucol = u.pn * BM + wc * 32;
        const size_t ubase = (size_t)urow * ldc + ucol;
        const char* bp = (const char*)(base + ubase); char* op = (char*)(out + ubase); char* zp = (char*)(zb + ubase);
        const char* sp = (const char*)(bstats + 2 * (size_t)urow); float* osp = ostats + 2 * (size_t)urow;
        const unsigned l4 = (unsigned)(fr * ldc + 8 * fq) * 4u, l2 = (unsigned)(fr * ldc + 8 * fq) * 2u, ls = (unsigned)fr * 8u;
        const int col0 = ucol + 8 * fq;
        f32x4 gv[2][2], cv[2][2];
#pragma unroll
        for (int bj = 0; bj < 2; ++bj)
#pragma unroll
            for (int n = 0; n < 2; ++n) { gv[bj][n] = *(const f32x4*)(bg + col0 + bj * HALF + 4 * n) * alpha;
                cv[bj][n] = *(const f32x4*)(bb + col0 + bj * HALF + 4 * n) * alpha + *(const f32x4*)(bias + col0 + bj * HALF + 4 * n); }
        f32x2 sv_c = *(const f32x2*)(sp + ls);
        f32x4 p0 = *(const f32x4*)(bp + l4), p1 = *(const f32x4*)(bp + l4 + 16);
#pragma unroll
        for (int g = 0; g < 8; ++g) { const int ai = g >> 2, m = g & 3; const int rr = ai * HALF + m * 16, rn = ((g + 1) >> 2) * HALF + ((g + 1) & 3) * 16;
            f32x2 sv_n = sv_c; if (g + 1 < 8) sv_n = *(const f32x2*)(sp + (size_t)rn * 8 + ls);
            float mu, r; stats_mr(sv_c, mu, r); float s1 = 0.f, s2 = 0.f;
#pragma unroll
            for (int bj = 0; bj < 2; ++bj) { const size_t ro = (size_t)rr * ldc + bj * HALF;
                f32x4 q0 = p0, q1 = p1;
                if (bj == 0) { q0 = *(const f32x4*)(bp + (ro + HALF) * 4 + l4); q1 = *(const f32x4*)(bp + (ro + HALF) * 4 + l4 + 16); }
                else if (g + 1 < 8) { q0 = *(const f32x4*)(bp + (size_t)rn * ldc * 4 + l4); q1 = *(const f32x4*)(bp + (size_t)rn * ldc * 4 + l4 + 16); }
                const f32x4 z0 = gv[bj][0] * ((p0 - mu) * r) + acc[ai][bj][m][0] + cv[bj][0], z1 = gv[bj][1] * ((p1 - mu) * r) + acc[ai][bj][m][1] + cv[bj][1];
                *(f32x4*)(op + ro * 4 + l4) = z0; *(f32x4*)(op + ro * 4 + l4 + 16) = z1;
                s1 += ((z0[0] + z0[1]) + (z0[2] + z0[3])) + ((z1[0] + z1[1]) + (z1[2] + z1[3]));
                s2 += ((z0[0] * z0[0] + z0[1] * z0[1]) + (z0[2] * z0[2] + z0[3] * z0[3])) + ((z1[0] * z1[0] + z1[1] * z1[1]) + (z1[2] * z1[2] + z1[3] * z1[3]));
                if (zb) { u32x4 w; w.x = cvt_pk_bf16(z0[0], z0[1]); w.y = cvt_pk_bf16(z0[2], z0[3]); w.z = cvt_pk_bf16(z1[0], z1[1]); w.w = cvt_pk_bf16(z1[2], z1[3]); *(u32x4*)(zp + ro * 2 + l2) = w; }
                p0 = q0; p1 = q1; }
            s1 += __shfl_xor(s1, 16); s2 += __shfl_xor(s2, 16); s1 += __shfl_xor(s1, 32); s2 += __shfl_xor(s2, 32);
            if (fq == 0) { atomicAdd(osp + 2 * (rr + fr), s1); atomicAdd(osp + 2 * (rr + fr) + 1, s2); }
            sv_c = sv_n; }
    }
};
}
#define LAS __attribute__((address_space(3)))
typedef unsigned short bf16;
typedef unsigned v4u __attribute__((ext_vector_type(4)));
typedef unsigned v2u __attribute__((ext_vector_type(2)));
typedef float f32x4 __attribute__((ext_vector_type(4)));
typedef short bf16x8 __attribute__((ext_vector_type(8)));
constexpr int NWAVES = 8, NTHR = 512;
constexpr int DM = 1024, MC = 32768, NCHUNK = 3, NLAYER = 2;
constexpr int PW = 4608;
constexpr int AW = 512, DFF = 2816, NUP = 5632, PROJ_W = 5120;
constexpr int C_Q = 0, C_K = 512, C_GCU = 1024  , C_GB = 1536, C_GA = 2560, C_GCC = 3584;
constexpr float ALPHA = 1.41421356237309515f, LN_EPS = 1e-5f, LOG2E = 1.4426950408889634f;
constexpr size_t OFF_WIN = 0, OFF_WV = OFF_WIN + (size_t)PW * DM, OFF_WA = OFF_WV + (size_t)AW * DM, OFF_WC = OFF_WA + (size_t)DM * AW,
                 OFF_WO = OFF_WC + (size_t)DM * AW, OFF_WUP = OFF_WO + (size_t)DM * DM, OFF_WDN = OFF_WUP + (size_t)NUP * DM, W_LAYER = (size_t)16 << 20;
static_assert(OFF_WDN + (size_t)DM * DFF <= W_LAYER, "weights per layer");
constexpr size_t MiB = (size_t)1 << 20;
constexpr size_t WS_W = 0, WS_XB = 64 * MiB, WS_PROJ = 128 * MiB, WS_VT = 416 * MiB, WS_YA = 448 * MiB, WS_YC = 480 * MiB, WS_MG = 512 * MiB,
                 WS_H = 128 * MiB, WS_G = 576 * MiB, WS_ZERO = 752 * MiB, ZERO_BYTES = 4 * MiB, WS_ST = WS_ZERO, WS_CS = WS_ZERO + 3 * MiB, WS_BAR = WS_ZERO + 3 * MiB + 512 * 1024, WS_ID = 756 * MiB, WS_END = 757 * MiB;
constexpr int CS_IN = 0, BC_IN = 5120, CS_UP = 10240, BC_UP = 10240 + 5632, CS_LAYER = 10240 + 2 * 5632;
static_assert((size_t)NCHUNK * NLAYER * 2 * MC * 2 * 4 <= 3 * MiB && (size_t)NLAYER * CS_LAYER * 4 <= MiB, "zeroed region");
static_assert(WS_PROJ + (size_t)MC * PW * 2 <= WS_VT && WS_H + (size_t)MC * NUP * 2 <= WS_YC && WS_G + (size_t)MC * DFF * 2 <= WS_ZERO, "ws map");
constexpr int LDS_BYTES = 147456;

__device__ __forceinline__ unsigned f2bf(float f) { unsigned u = __builtin_bit_cast(unsigned, f); return (u + 0x7fffu + ((u >> 16) & 1u)) >> 16; }
__device__ __forceinline__ unsigned pk2(float lo, float hi) { return f2bf(lo) | (f2bf(hi) << 16); }
__device__ __forceinline__ float wave_sum(float v) {
#pragma unroll
    for (int o = 1; o < 64; o <<= 1) v += __shfl_xor(v, o);
    return v;
}
using pg8::bf_lo; using pg8::bf_hi; using pg8::cvt_pk_bf16;

__device__ __forceinline__ void transpose_item(const float* W, int K, int N, bf16* WT, int rowadj, LAS float* scr, int item, int lane,
                                               const float* gk, const float* bk, const float* bias, float* cs, float* bc) {
    const int nblk = N / 32, kb = item / nblk, nb = item % nblk, k0 = 64 * kb, n0 = 32 * nb;
    float pcs = 0.f, pbc = 0.f;
    float wl_[32];
#pragma unroll
    for (int i = 0; i < 32; ++i) wl_[i] = __builtin_nontemporal_load(W + (size_t)(k0 + 2 * i + (lane >> 5)) * N + n0 + (lane & 31));
#pragma unroll
    for (int i = 0; i < 32; ++i) { const int kk = 2 * i + (lane >> 5); const float w = wl_[i];
        float wg = w; if (gk) wg = w * gk[k0 + kk]; scr[kk * 33 + (lane & 31)] = wg;
        if (cs) { pcs += __builtin_bit_cast(float, f2bf(wg) << 16); if (bk) pbc += bk[k0 + kk] * w; } }
    if (cs) { pcs += __shfl_xor(pcs, 32); pbc += __shfl_xor(pbc, 32); if (kb == 0) pbc += bias[n0 + (lane & 31)];
        if (lane < 32) { atomicAdd(cs + n0 + lane, pcs); atomicAdd(bc + n0 + lane, pbc); } }
    asm volatile("s_waitcnt lgkmcnt(0)" ::: "memory");
    const int c = lane & 7;
#pragma unroll
    for (int j = 0; j < 4; ++j) { const int n = (lane >> 3) + 8 * j; const LAS float* s = scr + (8 * c) * 33 + n;
        v4u o; o.x = pk2(s[0 * 33], s[1 * 33]); o.y = pk2(s[2 * 33], s[3 * 33]); o.z = pk2(s[4 * 33], s[5 * 33]); o.w = pk2(s[6 * 33], s[7 * 33]);
        *(v4u*)(WT + (size_t)(n0 + n + rowadj) * K + k0 + 8 * c) = o; }
    asm volatile("s_waitcnt lgkmcnt(0)" ::: "memory");
}

__device__ __forceinline__ const float* idptr(const unsigned char* ws, int off) { asm volatile("" : "+s"(off)); return (const float*)(ws + WS_ID) + off; }
struct Args { const float* in[21]; float* out; unsigned char* ws; int ph_lo, ph_hi; };
__device__ __forceinline__ const float* ldin(const Args& a, int i) { asm volatile("" : "+s"(i)); return a.in[i]; }

__device__ __forceinline__ void prologue_weights(const Args& a, LAS unsigned char* lds, int gw, int NGW, int wave, int lane) {
    LAS float* scr = (LAS float*)(lds + wave * 16384);
    constexpr int I_IN = (DM / 64) * (PROJ_W / 32), I_BR = (AW / 64) * (DM / 32), I_O = (DM / 64) * (DM / 32), I_UP = (DM / 64) * (NUP / 32), I_DN = (DFF / 64) * (DM / 32);
    constexpr int PER_LAYER = I_IN + 2 * I_BR + I_O + I_UP + I_DN;
    for (int it = gw; it < NLAYER * PER_LAYER; it += NGW) {
        const int l = it / PER_LAYER; int r = it % PER_LAYER;
        bf16* wl = (bf16*)(a.ws + WS_W) + (size_t)l * W_LAYER;
        float* csl = (float*)(a.ws + WS_CS) + (size_t)l * CS_LAYER;
        if (r < I_IN) { const int nb = r % (PROJ_W / 32), n0 = nb * 32; const float* W = ldin(a, 2) + (size_t)l * DM * PROJ_W;
            const float* gk = l > 0 ? ldin(a, 19) + (size_t)(l - 1) * DM : nullptr; const float* bk = l > 0 ? ldin(a, 20) + (size_t)(l - 1) * DM : nullptr;
            bf16* dst = (n0 >= 1024 && n0 < 1536) ? wl + OFF_WV : wl + OFF_WIN; int adj;
            if (n0 < 1024) adj = 0; else if (n0 < 1536) adj = -1024;
            else if (n0 < 2048) { const int j = (n0 - 1536) >> 7; adj = (1024 + 256 * j + ((n0 - 1536) & 127)) - n0; }
            else if (n0 < 2560) adj = 0;
            else if (n0 < 3072) { const int j = (n0 - 2560) >> 7; adj = (1024 + 256 * j + 128 + ((n0 - 2560) & 127)) - n0; }
            else adj = -512;
            transpose_item(W, DM, PROJ_W, dst, adj, scr, r, lane, gk, bk, ldin(a, 3) + (size_t)l * PROJ_W, csl + CS_IN, csl + BC_IN);
            continue; } r -= I_IN;
        if (r < I_BR) { transpose_item(ldin(a, 7) + (size_t)l * AW * DM, AW, DM, wl + OFF_WA, 0, scr, r, lane, nullptr, nullptr, nullptr, nullptr, nullptr); continue; } r -= I_BR;
        if (r < I_BR) { transpose_item(ldin(a, 8) + (size_t)l * AW * DM, AW, DM, wl + OFF_WC, 0, scr, r, lane, nullptr, nullptr, nullptr, nullptr, nullptr); continue; } r -= I_BR;
        if (r < I_O) { transpose_item(ldin(a, 9) + (size_t)l * DM * DM, DM, DM, wl + OFF_WO, 0, scr, r, lane, nullptr, nullptr, nullptr, nullptr, nullptr); continue; } r -= I_O;
        if (r < I_UP) { transpose_item(ldin(a, 13) + (size_t)l * DM * NUP, DM, NUP, wl + OFF_WUP, 0, scr, r, lane, ldin(a, 11) + (size_t)l * DM, ldin(a, 12) + (size_t)l * DM,
                                       ldin(a, 14) + (size_t)l * NUP, csl + CS_UP, csl + BC_UP); continue; } r -= I_UP;
        transpose_item(ldin(a, 17) + (size_t)l * DFF * DM, DFF, DM, wl + OFF_WDN, 0, scr, r, lane, nullptr, nullptr, nullptr, nullptr, nullptr);
    }
}
__device__ __forceinline__ void convert_rows(const float* x, bf16* xb, int nrows, int vcu, int NGW) {
    int t_ = threadIdx.x; asm volatile("" : "+v"(t_)); const int lane = t_ & 63, gw = vcu * NWAVES + __builtin_amdgcn_readfirstlane(t_ >> 6);
    for (int m = gw * 4; m < nrows; m += NGW * 4) {
        f32x4 v[4][4];
#pragma unroll
        for (int q = 0; q < 4; ++q) { const f32x4* xr = (const f32x4*)(x + (size_t)(m + q) * DM) + lane;
#pragma unroll
            for (int j = 0; j < 4; ++j) v[q][j] = __builtin_nontemporal_load(xr + 64 * j); }
#pragma unroll
        for (int q = 0; q < 4; ++q) { v2u* o = (v2u*)(xb + (size_t)(m + q) * DM) + lane;
#pragma unroll
            for (int j = 0; j < 4; ++j) { v2u w; w.x = cvt_pk_bf16(v[q][j][0], v[q][j][1]); w.y = cvt_pk_bf16(v[q][j][2], v[q][j][3]); o[64 * j] = w; } }
    }
}
__device__ __forceinline__ void ln_rows(float* z, bf16* xb, const float* g, const float* b, int nrows, int vcu, int NGW, bool write_xb) {
    int t_ = threadIdx.x; asm volatile("" : "+v"(t_)); const int lane = t_ & 63, gw = vcu * NWAVES + __builtin_amdgcn_readfirstlane(t_ >> 6);
    f32x4 gv[4], bv[4];
#pragma unroll
    for (int j = 0; j < 4; ++j) { gv[j] = ((const f32x4*)g)[64 * j + lane]; bv[j] = ((const f32x4*)b)[64 * j + lane]; }
    for (int m = gw * 2; m < nrows; m += NGW * 2) {
        f32x4 v[2][4];
#pragma unroll
        for (int q = 0; q < 2; ++q) { const f32x4* xr = (const f32x4*)(z + (size_t)(m + q) * DM) + lane;
#pragma unroll
            for (int j = 0; j < 4; ++j) v[q][j] = xr[64 * j]; }
#pragma unroll
        for (int q = 0; q < 2; ++q) { f32x4* xr = (f32x4*)(z + (size_t)(m + q) * DM) + lane; v2u* o = (v2u*)(xb + (size_t)(m + q) * DM) + lane;
            float s = 0.f;
#pragma unroll
            for (int j = 0; j < 4; ++j) s += (v[q][j][0] + v[q][j][1]) + (v[q][j][2] + v[q][j][3]);
            const float mean = wave_sum(s) * (1.f / DM); float s2 = 0.f;
#pragma unroll
            for (int j = 0; j < 4; ++j) { v[q][j] = v[q][j] - mean; s2 += (v[q][j][0] * v[q][j][0] + v[q][j][1] * v[q][j][1]) + (v[q][j][2] * v[q][j][2] + v[q][j][3] * v[q][j][3]); }
            const float rstd = 1.f / sqrtf(wave_sum(s2) * (1.f / DM) + LN_EPS);
#pragma unroll
            for (int j = 0; j < 4; ++j) { const f32x4 y = v[q][j] * rstd * gv[j] + bv[j]; xr[64 * j] = y;
                if (write_xb) { v2u w; w.x = cvt_pk_bf16(y[0], y[1]); w.y = cvt_pk_bf16(y[2], y[3]); o[64 * j] = w; } } }
    }
}
__device__ __forceinline__ void unpack8(const v4u w, float (&f)[8]) {
    f[0] = bf_lo(w.x); f[1] = bf_hi(w.x); f[2] = bf_lo(w.y); f[3] = bf_hi(w.y); f[4] = bf_lo(w.z); f[5] = bf_hi(w.z); f[6] = bf_lo(w.w); f[7] = bf_hi(w.w);
}
__device__ __forceinline__ void convbranch_phase(const bf16* proj, bf16* yc, const float* cw, const float* cb, int T, int vcu, int NT) {
    int t_ = threadIdx.x; asm volatile("" : "+v"(t_)); const int gtid = vcu * NTHR + t_;
    constexpr int NG = AW / 8, L = 16, R = MC / L;
    for (int item = gtid; item < NG * R; item += NT) {
        const int run = item / NG, ch = (item - run * NG) * 8, t0 = run * L;
        float w0[8], w1[8], w2[8], bb[8];
#pragma unroll
        for (int e = 0; e < 8; e += 4) { *(f32x4*)(w0 + e) = *(const f32x4*)(cw + ch + e); *(f32x4*)(w1 + e) = *(const f32x4*)(cw + AW + ch + e);
            *(f32x4*)(w2 + e) = *(const f32x4*)(cw + 2 * AW + ch + e); *(f32x4*)(bb + e) = *(const f32x4*)(cb + ch + e); }
        const bf16* p = proj + (size_t)t0 * PW + ch;
        float pp[8], pc[8], fu[8], fc[8];
        unpack8(*(const v4u*)(p + C_GCU), pc);
        if (t0 > 0) unpack8(*(const v4u*)(p - PW + C_GCU), pp);
        else {
#pragma unroll
          for (int e = 0; e < 8; ++e) pp[e] = 0.f; }
        for (int t = t0; t < t0 + L; t += 4) {
            const v4u z4 = (v4u){0u, 0u, 0u, 0u}; v4u un[4], gq[4];
#pragma unroll
            for (int q = 0; q < 4; ++q) { un[q] = z4; gq[q] = *(const v4u*)(p + (size_t)q * PW + C_GB);
                if (t + q + 1 < MC) un[q] = *(const v4u*)(p + (size_t)(q + 1) * PW + C_GCU); }
#pragma unroll
            for (int q = 0; q < 4; ++q) { const int tpos = (t + q) & (T - 1);
                float fg[8], pn[8], r[8]; unpack8(gq[q], fg); unpack8(un[q], pn);
                const float mp = tpos == 0 ? 0.f : 1.f, mn = tpos == T - 1 ? 0.f : 1.f;
#pragma unroll
                for (int e = 0; e < 8; ++e) { r[e] = fg[e] * (w0[e] * (pp[e] * mp) + w1[e] * pc[e] + w2[e] * (pn[e] * mn) + bb[e]); pp[e] = pc[e]; pc[e] = pn[e]; }
                v4u o; o.x = cvt_pk_bf16(r[0], r[1]); o.y = cvt_pk_bf16(r[2], r[3]); o.z = cvt_pk_bf16(r[4], r[5]); o.w = cvt_pk_bf16(r[6], r[7]);
                *(v4u*)(yc + (size_t)(t + q) * AW + ch) = o; }
            p += 4 * (size_t)PW;
        }
    }
}
__device__ __forceinline__ float gelu_tanh(float x) {
    const float u = x * (0.7978845608028654f + 0.035677408136300125f * x * x);
    return x * __builtin_amdgcn_rcpf(1.0f + __builtin_amdgcn_exp2f(-2.0f * LOG2E * u));
}
__device__ __forceinline__ void ffnconv_phase(const bf16* h, bf16* gout, const float* cw, const float* cb, int T, int vcu, int NT) {
    int t_ = threadIdx.x; asm volatile("" : "+v"(t_)); const int gtid = vcu * NTHR + t_;
    constexpr int NG = DFF / 8, L = 96, R = (MC + L - 1) / L, RS = 8;
    static_assert(L % RS == 0 && MC % RS == 0, "rows are walked RS at a time");
    for (int item = gtid; item < NG * R; item += NT) {
        const int run = item / NG, ch = (item - run * NG) * 8, t0 = run * L, t1 = (t0 + L < MC) ? t0 + L : MC;
        float wg0[8], wg1[8], wg2[8], bg[8], wv0[8], wv1[8], wv2[8], bv[8];
#pragma unroll
        for (int e = 0; e < 8; e += 4) {
            *(f32x4*)(wg0 + e) = *(const f32x4*)(cw + ch + e); *(f32x4*)(wg1 + e) = *(const f32x4*)(cw + NUP + ch + e); *(f32x4*)(wg2 + e) = *(const f32x4*)(cw + 2 * NUP + ch + e); *(f32x4*)(bg + e) = *(const f32x4*)(cb + ch + e);
            *(f32x4*)(wv0 + e) = *(const f32x4*)(cw + DFF + ch + e); *(f32x4*)(wv1 + e) = *(const f32x4*)(cw + NUP + DFF + ch + e); *(f32x4*)(wv2 + e) = *(const f32x4*)(cw + 2 * NUP + DFF + ch + e); *(f32x4*)(bv + e) = *(const f32x4*)(cb + DFF + ch + e); }
        const bf16* p = h + (size_t)t0 * NUP + ch;
        const v4u z4 = (v4u){0u, 0u, 0u, 0u};
        v4u gp_ = z4, vp_ = z4, gc_ = *(const v4u*)(p), vc_ = *(const v4u*)(p + DFF);
        if (t0 > 0) { gp_ = *(const v4u*)(p - NUP); vp_ = *(const v4u*)(p - NUP + DFF); }
        for (int t = t0; t < t1; t += RS) {
            v4u gn_[RS], vn_[RS];
#pragma unroll
            for (int q = 0; q < RS; ++q) { gn_[q] = z4; vn_[q] = z4; if (t + q + 1 < MC) { gn_[q] = __builtin_nontemporal_load((const v4u*)(p + (size_t)(q + 1) * NUP)); vn_[q] = __builtin_nontemporal_load((const v4u*)(p + (size_t)(q + 1) * NUP + DFF)); } }
#pragma unroll
            for (int q = 0; q < RS; ++q) {
                const int tpos = (t + q) & (T - 1);
                const float mp = tpos == 0 ? 0.f : 1.f, mn = tpos == T - 1 ? 0.f : 1.f;
                float a0[8], a1[8], a2[8], b0[8], b1[8], b2[8], r[8];
                unpack8(gp_, a0); unpack8(gc_, a1); unpack8(gn_[q], a2); unpack8(vp_, b0); unpack8(vc_, b1); unpack8(vn_[q], b2);
#pragma unroll
                for (int e = 0; e < 8; ++e) { const float hg = wg0[e] * (a0[e] * mp) + wg1[e] * a1[e] + wg2[e] * (a2[e] * mn) + bg[e];
                    const float hv = wv0[e] * (b0[e] * mp) + wv1[e] * b1[e] + wv2[e] * (b2[e] * mn) + bv[e]; r[e] = gelu_tanh(hg) * hv; }
                v4u o; o.x = cvt_pk_bf16(r[0], r[1]); o.y = cvt_pk_bf16(r[2], r[3]); o.z = cvt_pk_bf16(r[4], r[5]); o.w = cvt_pk_bf16(r[6], r[7]);
                *(v4u*)(gout + (size_t)(t + q) * DFF + ch) = o;
                gp_ = gc_; gc_ = gn_[q]; vp_ = vc_; vc_ = vn_[q]; }
            p += RS * (size_t)NUP;
        }
    }
}
__device__ __forceinline__ void attn_phase(const bf16* __restrict__ proj, const bf16* __restrict__ vt, bf16* __restrict__ ya, const float* __restrict__ rpb, int T, int vcu, int G, LAS unsigned char* lds) {
    int t_ = threadIdx.x; asm volatile("" : "+v"(t_)); const int lane = t_ & 63, wave = __builtin_amdgcn_readfirstlane(t_ >> 6);
    LAS float* tbl = (LAS float*)lds;
    for (int idx = wave * 64 + lane; idx < 8 * 15 * 31; idx += NTHR) tbl[idx] = rpb[idx] * LOG2E;
    __syncthreads();
    const int rows = T >> 6, nrgp = rows >> 4;
    const int n = lane & 15, q4 = lane >> 4, c = wave & 3, q0 = c * 16, cs = (c == 0) ? 0 : (c == 1) ? 8 : (c == 2) ? 24 : 32;
    const float SC = 0.125f * LOG2E;
    const unsigned qlane = (unsigned)(n * PW + 8 * q4) * 2u, klane = (unsigned)((8 * (n >> 2) + (n & 3)) * PW + 8 * q4) * 2u, vlane = (unsigned)(n * MC + 8 * q4) * 2u, olane = (unsigned)(n * AW + 4 * q4) * 2u;
    unsigned dpack0 = 0u, dpack1 = 0u, vmask = 0u;
    { const int qj = q0 + n; int js = qj - 8; js = js < 0 ? 0 : js; js = js > 48 ? 48 : js;
#pragma unroll
      for (int hf = 0; hf < 2; ++hf)
#pragma unroll
          for (int j = 0; j < 4; ++j) { const int kj = cs + 8 * q4 + 4 * hf + j; const bool v = (kj >= js) && (kj < js + 16); int dc = kj - qj + 15; dc = dc < 0 ? 0 : dc; dc = dc > 30 ? 30 : dc;
              if (hf == 0) dpack0 |= (unsigned)dc << (8 * j); else dpack1 |= (unsigned)dc << (8 * j); vmask |= (v ? 1u : 0u) << (hf * 4 + j); } }
    asm volatile("" : "+v"(dpack0), "+v"(dpack1), "+v"(vmask));
    for (int wt = vcu; wt < 256; wt += G) {
        const int rgp = wt % nrgp, h = (wt / nrgp) & 7, s = wt / (nrgp * 8), rg = rgp * 2 + (wave >> 2);
        const LAS float* tbh = tbl + h * 15 * 31;
        for (int pass = 0; pass < 2; ++pass) {
            const int i0 = rg * 8 + pass * 4;
            int rsj[4];
#pragma unroll
            for (int j = 0; j < 4; ++j) { int r_ = i0 + j - 4; r_ = r_ < 0 ? 0 : r_; r_ = r_ > rows - 8 ? rows - 8 : r_; rsj[j] = r_; }
            const int ka0 = rsj[0], ka1 = rsj[3] + 7;
            const size_t tok0 = (size_t)s * T;
            bf16x8 qf[4][2];
#pragma unroll
            for (int j = 0; j < 4; ++j) { const char* qb = (const char*)(proj + (tok0 + (size_t)(i0 + j) * 64 + q0) * PW + C_Q + h * 64); qf[j][0] = *(const bf16x8*)(qb + qlane); qf[j][1] = *(const bf16x8*)(qb + qlane + 64); }
            const char* kb = (const char*)(proj + (tok0 + cs) * PW + C_K + h * 64);
            const char* vb = (const char*)(vt + (size_t)(h * 64) * MC + tok0 + cs);
            f32x4 o[4][4]; float mrun[4], lrun[4];
#pragma unroll
            for (int j = 0; j < 4; ++j) { mrun[j] = -INFINITY; lrun[j] = 0.f;
#pragma unroll
                for (int dt = 0; dt < 4; ++dt) o[j][dt] = (f32x4){0.f, 0.f, 0.f, 0.f}; }
            bf16x8 kf[2][2]; v4u vf[4];
            { const char* kp = kb + (size_t)ka0 * 64 * PW * 2;
#pragma unroll
              for (int hf = 0; hf < 2; ++hf) { kf[hf][0] = *(const bf16x8*)(kp + (size_t)(4 * hf) * PW * 2 + klane); kf[hf][1] = *(const bf16x8*)(kp + (size_t)(4 * hf) * PW * 2 + klane + 64); }
            }
            for (int ka = ka0; ka <= ka1; ++ka) {
                bf16x8 kn[2][2];
#pragma unroll
                for (int hf = 0; hf < 2; ++hf) { kn[hf][0] = kf[hf][0]; kn[hf][1] = kf[hf][1]; }
                { const char* vp = vb + (size_t)ka * 64 * 2;
#pragma unroll
                  for (int dt = 0; dt < 4; ++dt) vf[dt] = *(const v4u*)(vp + (size_t)(16 * dt) * MC * 2 + vlane); }
                if (ka < ka1) { const char* kp = kb + (size_t)(ka + 1) * 64 * PW * 2;
#pragma unroll
                    for (int hf = 0; hf < 2; ++hf) { kn[hf][0] = *(const bf16x8*)(kp + (size_t)(4 * hf) * PW * 2 + klane); kn[hf][1] = *(const bf16x8*)(kp + (size_t)(4 * hf) * PW * 2 + klane + 64); } }
#pragma unroll
                for (int j = 0; j < 4; ++j) { const int kr = ka - rsj[j];
                    if (kr >= 0 && kr < 8) {
                        f32x4 st[2];
#pragma unroll
                        for (int hf = 0; hf < 2; ++hf) { const f32x4 t = __builtin_amdgcn_mfma_f32_16x16x32_bf16(kf[hf][0], qf[j][0], (f32x4){0.f, 0.f, 0.f, 0.f}, 0, 0, 0);
                            st[hf] = __builtin_amdgcn_mfma_f32_16x16x32_bf16(kf[hf][1], qf[j][1], t, 0, 0, 0); }
                        const LAS float* tb = tbh + (ka - i0 - j + 7) * 31;
                        float mloc = -INFINITY;
#pragma unroll
                        for (int hf = 0; hf < 2; ++hf)
#pragma unroll
                            for (int e = 0; e < 4; ++e) { const unsigned dc = ((hf == 0 ? dpack0 : dpack1) >> (8 * e)) & 0xffu; const float b = tb[dc];
                                const float v = ((vmask >> (hf * 4 + e)) & 1u) ? st[hf][e] * SC + b : -INFINITY; st[hf][e] = v; mloc = fmaxf(mloc, v); }
                        mloc = fmaxf(mloc, __shfl_xor(mloc, 16)); mloc = fmaxf(mloc, __shfl_xor(mloc, 32));
                        const float mnew = fmaxf(mrun[j], mloc), alpha = __builtin_amdgcn_exp2f(mrun[j] - mnew); mrun[j] = mnew;
                        float p[8], psum = 0.f;
#pragma unroll
                        for (int hf = 0; hf < 2; ++hf)
#pragma unroll
                            for (int e = 0; e < 4; ++e) { p[hf * 4 + e] = __builtin_amdgcn_exp2f(st[hf][e] - mnew); psum += p[hf * 4 + e]; }
                        lrun[j] = lrun[j] * alpha + psum;
                        v4u w; w.x = cvt_pk_bf16(p[0], p[1]); w.y = cvt_pk_bf16(p[2], p[3]); w.z = cvt_pk_bf16(p[4], p[5]); w.w = cvt_pk_bf16(p[6], p[7]);
                        const bf16x8 pk = __builtin_bit_cast(bf16x8, w);
#pragma unroll
                        for (int dt = 0; dt < 4; ++dt) o[j][dt] = __builtin_amdgcn_mfma_f32_16x16x32_bf16(__builtin_bit_cast(bf16x8, vf[dt]), pk, o[j][dt] * alpha, 0, 0, 0);
                    } }
#pragma unroll
                for (int hf = 0; hf < 2; ++hf) { kf[hf][0] = kn[hf][0]; kf[hf][1] = kn[hf][1]; }
            }
#pragma unroll
            for (int j = 0; j < 4; ++j) { float l = lrun[j]; l += __shfl_xor(l, 16); l += __shfl_xor(l, 32); const float inv = 1.0f / l;
                char* ob = (char*)(ya + (tok0 + (size_t)(i0 + j) * 64 + q0) * AW + h * 64);
#pragma unroll
                for (int dt = 0; dt < 4; ++dt) { v2u w; w.x = cvt_pk_bf16(o[j][dt][0] * inv, o[j][dt][1] * inv); w.y = cvt_pk_bf16(o[j][dt][2] * inv, o[j][dt][3] * inv); *(v2u*)(ob + olane + 32 * dt) = w; } }
        }
    }
}
#define XB_TMO      128
#define XB_XCNT(j)  (256  + 64 * (j))
#define XB_XSUB(j)  (1280 + 64 * (j))
#define XB_XGEN(j)  (2304 + 64 * (j))
#define XB_TOP      3328
#define XB_TOPGEN   3392
#define XCD_BAR_WORDS 3456
#define XB_SPIN_CAP (1u << 18)

__device__ __forceinline__ unsigned xb_ld(unsigned* p)              { return __hip_atomic_load(p, __ATOMIC_RELAXED, __HIP_MEMORY_SCOPE_AGENT); }
__device__ __forceinline__ unsigned xb_add(unsigned* p, unsigned v) { return __hip_atomic_fetch_add(p, v, __ATOMIC_RELAXED, __HIP_MEMORY_SCOPE_AGENT); }
__device__ __forceinline__ unsigned xb_xcc_id() { return (unsigned)__builtin_amdgcn_s_getreg((3 << 11) | 20) & 0xFu; }
#define XB_SPIN(cond, bar) do { unsigned _sp = 0; while (cond) { __builtin_amdgcn_s_sleep(1); \
    if ((++_sp & 255u) == 0u) { if (xb_ld(&(bar)[XB_TMO])) break; if (_sp > XB_SPIN_CAP) { atomicAdd(&(bar)[XB_TMO], 1u); break; } } } } while (0)

struct XcdBarrier {
    unsigned* bar; unsigned x;
    volatile LAS unsigned* st;
};

__device__ __forceinline__ XcdBarrier xcd_barrier_post(unsigned* bar, volatile LAS unsigned* st) {
    XcdBarrier b; b.bar = bar; b.x = xb_xcc_id(); b.st = st;
    if (threadIdx.x == 0) (void)xb_add(&bar[XB_XCNT(b.x)], 1u);
    return b;
}
__device__ __forceinline__ void xcd_barrier_complete(unsigned* bar, unsigned x, unsigned& nloc, unsigned& nx) {
    const unsigned G = gridDim.x * gridDim.y * gridDim.z;
    unsigned sum, cnt, mine, sp = 0u;
    for (;;) {
        sum = 0u; cnt = 0u; mine = 0u;
#pragma unroll
        for (unsigned j = 0; j < 16; ++j) { const unsigned c = xb_ld(&bar[XB_XCNT(j)]); sum += c; cnt += (c > 0u) ? 1u : 0u; mine = (j == x) ? c : mine; }
        if (sum == G) break;
        __builtin_amdgcn_s_sleep(1);
        if ((++sp & 255u) == 0u) { if (xb_ld(&bar[XB_TMO])) break; if (sp > XB_SPIN_CAP) { atomicAdd(&bar[XB_TMO], 1u); break; } }
    }
    nloc = mine > 0u ? mine : 1u; nx = cnt > 0u ? cnt : 1u;
}

__device__ __forceinline__ void xcd_barrier(const XcdBarrier& b) {
    asm volatile("s_waitcnt vmcnt(0)" ::: "memory");
    __syncthreads();
    if (threadIdx.x == 0) {
        unsigned* bar = b.bar;
        __builtin_amdgcn_s_waitcnt(0);
        unsigned nloc = b.st[0], nx = b.st[1];
        if (nloc == 0u) { xcd_barrier_complete(bar, b.x, nloc, nx); b.st[0] = nloc; b.st[1] = nx; }
        const unsigned old = xb_add(&bar[XB_XSUB(b.x)], 1u);
        const unsigned gen = old / nloc;
        if (old + 1u == (gen + 1u) * nloc) {
            __builtin_amdgcn_fence(__ATOMIC_RELEASE, "agent");
            asm volatile("s_waitcnt vmcnt(0)" ::: "memory");
            const unsigned og = xb_add(&bar[XB_TOP], 1u);
            const unsigned tg = og / nx;
            if (og + 1u == (tg + 1u) * nx) xb_add(&bar[XB_TOPGEN], 1u);
            else XB_SPIN(xb_ld(&bar[XB_TOPGEN]) == tg, bar);
            __builtin_amdgcn_fence(__ATOMIC_ACQUIRE, "agent");
            xb_add(&bar[XB_XGEN(b.x)], 1u);
            asm volatile("s_waitcnt vmcnt(0)" ::: "memory");
        } else {
            XB_SPIN(xb_ld(&bar[XB_XGEN(b.x)]) == gen, bar);
            __builtin_amdgcn_fence(__ATOMIC_ACQUIRE, "agent");
            asm volatile("s_waitcnt vmcnt(0)" ::: "memory");
        }
    }
    __syncthreads();
}
#define IN(i) ldin(a, i)
__global__ void __launch_bounds__(NTHR, 2) mega_fwd(Args a) {
    extern __shared__ __attribute__((aligned(16))) unsigned char lds_raw[];
    LAS unsigned char* lds = (LAS unsigned char*)lds_raw;
    cg::grid_group grid = cg::this_grid();
    const int tid = threadIdx.x, lane0 = tid & 63, wave0 = __builtin_amdgcn_readfirstlane(tid >> 6);
    const int G = gridDim.x, bx = blockIdx.x;
    const int vcu = (G % 8 == 0) ? (bx % 8) * (G / 8) + bx / 8 : bx;
    const int gw0 = vcu * NWAVES + wave0, NGW = G * NWAVES, gtid0 = vcu * NTHR + tid, NT = G * NTHR;
    unsigned char* ws = a.ws;
    bf16* XB = (bf16*)(ws + WS_XB); bf16* PROJ = (bf16*)(ws + WS_PROJ); bf16* VT = (bf16*)(ws + WS_VT); bf16* YA = (bf16*)(ws + WS_YA); bf16* YC = (bf16*)(ws + WS_YC);
    bf16* MG = (bf16*)(ws + WS_MG); bf16* HB = (bf16*)(ws + WS_H); bf16* GB = (bf16*)(ws + WS_G);
    int ph = 0;
    volatile LAS unsigned* bst = (volatile LAS unsigned*)(lds + 131072 + 64);
    if (tid < 2) bst[tid] = 0u;
    __syncthreads();
    XcdBarrier xbar = xcd_barrier_post((unsigned*)(ws + WS_BAR), bst);
#define SEAM() do { xcd_barrier(xbar); } while (0)
#define IDST idptr(ws, 0)
#define ONES idptr(ws, 2 * MC)
#define ZEROS idptr(ws, 2 * MC + DM)
#define STATS(ll, sub) ((float*)(ws + WS_ST) + (size_t)((chunk * NLAYER + (ll)) * 2 + (sub)) * MC * 2)

    prologue_weights(a, lds, gw0, NGW, wave0, lane0);
    convert_rows(IN(0), XB, MC, vcu, NGW);
    { float* idp = (float*)(ws + WS_ID);
      for (int i = gtid0; i < MC; i += NT) { idp[2 * i] = 0.f; idp[2 * i + 1] = 1024.0f * (1.0f - 1e-5f); }
      for (int i = gtid0; i < DM; i += NT) { idp[2 * MC + i] = 1.f; idp[2 * MC + DM + i] = 0.f; } }
    grid.sync();

    for (int chunk = 0; chunk < NCHUNK; ++chunk) {
        const float* xin = (chunk == 0) ? IN(0) : IN(1) + (size_t)(chunk - 1) * MC * DM;
        float* outc = a.out + (size_t)chunk * MC * DM;
        const int T = (chunk == 0) ? 8192 : 2048;
        for (int l = 0; l < NLAYER; ++l) {
            const bf16* wl = (const bf16*)(ws + WS_W) + (size_t)l * W_LAYER;
            const float* csl = (const float*)(ws + WS_CS) + (size_t)l * CS_LAYER;
            { pg8::Gemm g{XB, wl + OFF_WIN, MC, PW, DM, DM, DM}; pg8::StaticOrder S; S.init(MC, PW, G, bx);
              pg8::EpiLNP1 E{PROJ, PW, csl + CS_IN, csl + BC_IN, l > 0 ? STATS(l - 1, 1) : IDST};
              pg8::gemm_phase<pg8::EpiLNP1, pg8::StaticOrder, true, true>(lds, g, S, E); }
            { pg8::Gemm g{wl + OFF_WV, XB, AW, MC, DM, DM, DM}; pg8::StaticOrder S; S.init(AW, MC, G, bx);
              pg8::EpiLNT E{VT, MC, csl + CS_IN + 1024, csl + BC_IN + 1024, l > 0 ? STATS(l - 1, 1) : IDST};
              pg8::gemm_phase<pg8::EpiLNT, pg8::StaticOrder, true, true>(lds, g, S, E); }
            SEAM();
            attn_phase(PROJ, VT, YA, IN(4) + (size_t)l * 8 * 15 * 31, T, vcu, G, lds);
            convbranch_phase(PROJ, YC, IN(5) + (size_t)l * 3 * AW, IN(6) + (size_t)l * AW, T, vcu, NT);
            SEAM();
            { pg8::Gemm g{YA, wl + OFF_WA, MC, DM, AW, AW, AW, YC, wl + OFF_WC}; pg8::PairedOrder S; S.init(MC, DM, G, bx);
              pg8::EpiGateDual E{MG, DM, PROJ + C_GA, PROJ + C_GCC, PW};
              pg8::gemm_phase<pg8::EpiGateDual, pg8::PairedOrder, true, true>(lds, g, S, E); }
            SEAM();
            { pg8::Gemm g{MG, wl + OFF_WO, MC, DM, DM, DM, DM}; pg8::StaticOrder S; S.init(MC, DM, G, bx);
              pg8::EpiRes2 E{(l == 0) ? xin : outc, outc, XB, DM, IN(10) + (size_t)l * DM, l > 0 ? STATS(l - 1, 1) : IDST,
                             l > 0 ? IN(19) + (size_t)(l - 1) * DM : ONES, l > 0 ? IN(20) + (size_t)(l - 1) * DM : ZEROS, STATS(l, 0)};
              pg8::gemm_phase<pg8::EpiRes2, pg8::StaticOrder, true, true>(lds, g, S, E); }
            SEAM();
            { pg8::Gemm g{XB, wl + OFF_WUP, MC, NUP, DM, DM, DM}; pg8::StaticOrder S; S.init(MC, NUP, G, bx);
              pg8::EpiLN E{HB, NUP, csl + CS_UP, csl + BC_UP, 1 << 30, 0, STATS(l, 0)};
              pg8::gemm_phase<pg8::EpiLN, pg8::StaticOrder, true, true>(lds, g, S, E); }
            SEAM();
            ffnconv_phase(HB, GB, IN(15) + (size_t)l * 3 * NUP, IN(16) + (size_t)l * NUP, T, vcu, NT);
            if (l + 1 == NLAYER && chunk + 1 < NCHUNK) convert_rows(IN(1) + (size_t)chunk * MC * DM, XB, MC, vcu, NGW);
            SEAM();
            { pg8::Gemm g{GB, wl + OFF_WDN, MC, DM, DFF, DFF, DFF}; pg8::StaticOrder S; S.init(MC, DM, G, bx);
              pg8::EpiRes2 E{outc, outc, (l + 1 < NLAYER) ? XB : nullptr, DM, IN(18) + (size_t)l * DM, STATS(l, 0), IN(11) + (size_t)l * DM, IN(12) + (size_t)l * DM, STATS(l, 1)};
              pg8::gemm_phase<pg8::EpiRes2, pg8::StaticOrder, true, true>(lds, g, S, E); }
            SEAM();
            if (l + 1 == NLAYER) {
                ln_rows(outc, XB, IN(19) + (size_t)l * DM, IN(20) + (size_t)l * DM, MC, vcu, NGW, false);
            }
        }
    }
    (void)ph;
}

extern "C" void kernel_launch(void* const* d_in, const int* in_sizes, int n_in, void* d_out, int out_size, void* d_ws, size_t ws_size, hipStream_t stream) {
    static int grid = 0;
    if (grid == 0) {
        if (n_in != 21 || out_size != NCHUNK * MC * DM || ws_size < WS_END) { fprintf(stderr, "kernel_launch: unexpected shapes: n_in %d out %d ws %zu\n", n_in, out_size, ws_size); grid = -1; return; }
        int dev = 0, cus = 0, per_cu = 0;
        if (hipGetDevice(&dev) != hipSuccess || hipDeviceGetAttribute(&cus, hipDeviceAttributeMultiprocessorCount, dev) != hipSuccess) { grid = -1; return; }
        if (hipFuncSetAttribute((const void*)mega_fwd, hipFuncAttributeMaxDynamicSharedMemorySize, LDS_BYTES) != hipSuccess) { fprintf(stderr, "kernel_launch: hipFuncSetAttribute failed\n"); grid = -1; return; }
        if (hipOccupancyMaxActiveBlocksPerMultiprocessor(&per_cu, (const void*)mega_fwd, NTHR, LDS_BYTES) != hipSuccess || per_cu < 1) { fprintf(stderr, "kernel_launch: occupancy query says %d\n", per_cu); per_cu = 1; }
        (void)hipGetLastError();
        grid = cus;
    }
    if (grid < 0) return;
    if (hipMemsetAsync((char*)d_ws + WS_ZERO, 0, ZERO_BYTES, stream) != hipSuccess) { fprintf(stderr, "kernel_launch: memset failed\n"); return; }
    Args a{};
    for (int i = 0; i < 21; ++i) a.in[i] = (const float*)d_in[i];
    a.out = (float*)d_out; a.ws = (unsigned char*)d_ws; a.ph_lo = 0; a.ph_hi = 0;
    void* args[] = {&a};
    hipError_t e = hipLaunchCooperativeKernel((const void*)mega_fwd, dim3(grid), dim3(NTHR), args, LDS_BYTES, stream);
    if (e != hipSuccess) fprintf(stderr, "kernel_launch: cooperative launch failed: %s (grid %d)\n", hipGetErrorString(e), grid);
}
```

```cpp
#include <hip/hip_runtime.h>
#include <hip/hip_cooperative_groups.h>
#include <cstdio>
#include <cstdint>
namespace cg = cooperative_groups;
namespace pg8 {
#define PG8_LAS __attribute__((address_space(3)))
typedef unsigned short bf16_t;
typedef short bf16x8 __attribute__((ext_vector_type(8)));
typedef float f32x4 __attribute__((ext_vector_type(4)));
typedef unsigned u32x4 __attribute__((ext_vector_type(4)));
constexpr int BM = 256, BK = 64, HALF = 128, HTB = HALF * BK * 2  , STAGE_BYTES = 8 * HTB, NXCD = 8, WGM = 8;

__host__ __device__ __forceinline__ int lds_byte(int r, int c) { const int st = (r >> 4) * 2 + (c >> 5), rr = r & 15, cc = c & 31, ob = rr * 64 + cc * 2; return st * 1024 + (ob ^ (((ob >> 9) & 1) << 5)); }
__host__ __device__ __forceinline__ void stage_rc(int b, int& R, int& C) { const int st = b / 1024, sb = b % 1024, swz = sb ^ (((sb >> 9) & 1) << 5); R = (st >> 1) * 16 + swz / 64; C = (st & 1) * 32 + (swz % 64) / 2; }
__host__ __device__ __forceinline__ int perm32(int rho) { const int n = rho >> 4, i = rho & 15; return 8 * (i >> 2) + 4 * n + (i & 3); }

struct Unit { int pm, pn, part; };
struct Gemm { const bf16_t* A; const bf16_t* Bt; int M, N, K, lda, ldb; const bf16_t* A2; const bf16_t* Bt2; };

struct StaticOrder {
    int nM, nN, nwg, G, c;
    __host__ __device__ void init(int M, int N, int G_, int c_) { nM = M / BM; nN = N / BM; nwg = nM * nN; G = G_; c = c_; }
    __host__ __device__ bool next(int i, Unit& u) const { return at((long)i * G + c, u); }
    __host__ __device__ bool at(long L, Unit& u) const {
        if (L >= nwg) return false;
        int wgid = (int)L; { const int q = nwg / NXCD, r = nwg % NXCD, xcd = wgid % NXCD, off = wgid / NXCD; wgid = (xcd < r ? xcd * (q + 1) : r * (q + 1) + (xcd - r) * q) + off; }
        const int nig = WGM * nN, gid = wgid / nig, fm = gid * WGM, gsz = (nM - fm) < WGM ? (nM - fm) : WGM;
        u.pm = fm + ((wgid % nig) % gsz); u.pn = (wgid % nig) / gsz; u.part = 0; return true;
    }
    __device__ __forceinline__ void a_ready(const Unit&) const {}
    __device__ __forceinline__ void done(const Unit&) const {}
};

__device__ __forceinline__ unsigned cvt_pk_bf16(float lo, float hi) { unsigned r; asm volatile("v_cvt_pk_bf16_f32 %0, %1, %2" : "=v"(r) : "v"(lo), "v"(hi)); return r; }
typedef float f32x2 __attribute__((ext_vector_type(2)));
template <class Epi, class Sched, bool ALIGN_EPI = false, bool SP2 = false>
__device__ __forceinline__ void gemm_phase(PG8_LAS unsigned char* lds, const Gemm g, const Sched& S, const Epi& E) {
    int tid_ = threadIdx.x; asm volatile("" : "+v"(tid_));
    const int tid = tid_, wid = __builtin_amdgcn_readfirstlane(tid >> 6), lane = tid & 63, wr = wid >> 2, wc = wid & 3, fr = lane & 15, fq = lane >> 4;
    const int K = g.K, nt = K / BK;
    unsigned voffA[2], voffB[2];
#pragma unroll
    for (int i = 0; i < 2; ++i) { int R, C; stage_rc(tid * 16 + i * 8192, R, C); const int Rb = Epi::PERM ? ((R & ~31) + perm32(R & 31)) : R;
        voffA[i] = (unsigned)(R * g.lda + C) * 2u; voffB[i] = (unsigned)(Rb * g.ldb + C) * 2u; }
    const size_t kstep = (size_t)(BK * 2);
    const size_t hstepA = (size_t)HALF * g.lda * 2, hstepB = (size_t)HALF * g.ldb * 2;
    const size_t tstepA = 2 * hstepA, tstepB = 2 * hstepB;
    const unsigned ldsw = (unsigned)wid * 1024u;
    const int aoff = lds_byte(wr * 64 + fr, fq * 8), boff = lds_byte(wc * 32 + fr, fq * 8);
#define PG8_SA(b, h) (((b) * 2 + (h)) * HTB)
#define PG8_SB(b, h) ((4 + (b) * 2 + (h)) * HTB)
#define PG8_STAGE(bufoff, gbase, voff) do { _Pragma("unroll") for (int _i = 0; _i < 2; ++_i) \
        __builtin_amdgcn_global_load_lds((const unsigned*)((const char*)(gbase) + (voff)[_i]), (PG8_LAS unsigned*)(lds + (bufoff) + ldsw + _i * 8192), 16, 0, 0); } while (0)
#define PG8_LDA(dst, b, h) do { _Pragma("unroll") for (int m = 0; m < 4; ++m) _Pragma("unroll") for (int k = 0; k < 2; ++k) dst[m][k] = *(const PG8_LAS bf16x8*)(lds + PG8_SA(b, h) + aoff + m * 2048 + k * 1024); } while (0)
#define PG8_LDB(dst, b, h) do { _Pragma("unroll") for (int n = 0; n < 2; ++n) _Pragma("unroll") for (int k = 0; k < 2; ++k) dst[n][k] = *(const PG8_LAS bf16x8*)(lds + PG8_SB(b, h) + boff + n * 2048 + k * 1024); } while (0)
#define PG8_MMA(ai, bj, At, Bt) do { __builtin_amdgcn_s_setprio(1); _Pragma("unroll") for (int m = 0; m < 4; ++m) _Pragma("unroll") for (int n = 0; n < 2; ++n) _Pragma("unroll") for (int k = 0; k < 2; ++k) \
        acc[ai][bj][m][n] = __builtin_amdgcn_mfma_f32_16x16x32_bf16(Bt[n][k], At[m][k], acc[ai][bj][m][n], 0, 0, 0); __builtin_amdgcn_s_setprio(0); } while (0)
#define PG8_WAIT_V(n) asm volatile("s_waitcnt vmcnt(" #n ")" ::: "memory")
#define PG8_WAIT_L(n) asm volatile("s_waitcnt lgkmcnt(" #n ")" ::: "memory")
#define PG8_BAR __builtin_amdgcn_s_barrier()
#define PG8_SCHED __builtin_amdgcn_sched_barrier(0)
    Unit cur, nxt; int ui = 0;
    if (!S.next(0, cur)) return;
    f32x4 acc[2][2][4][2];
#pragma unroll
    for (int a = 0; a < 2; ++a)
#pragma unroll
        for (int b = 0; b < 2; ++b)
#pragma unroll
            for (int m = 0; m < 4; ++m)
#pragma unroll
                for (int n = 0; n < 2; ++n) acc[a][b][m][n] = (f32x4){0.f, 0.f, 0.f, 0.f};
    bf16x8 At[4][2], B0[2][2], B1[2][2];
    const char* cA = (const char*)((Epi::MULTI && cur.part) ? g.A2 : g.A) + (size_t)cur.pm * tstepA; const char* cB = (const char*)((Epi::MULTI && cur.part) ? g.Bt2 : g.Bt) + (size_t)cur.pn * tstepB;
    S.a_ready(cur);
    if constexpr (SP2) {
        PG8_STAGE(PG8_SB(0, 0), cB, voffB); PG8_STAGE(PG8_SB(0, 1), cB + hstepB, voffB); PG8_STAGE(PG8_SA(0, 0), cA, voffA); PG8_STAGE(PG8_SA(0, 1), cA + hstepA, voffA);
        if (wr == 1) PG8_BAR;
        PG8_WAIT_V(2); PG8_BAR;
        PG8_STAGE(PG8_SB(1, 0), cB + kstep, voffB); PG8_STAGE(PG8_SA(1, 0), cA + kstep, voffA); PG8_STAGE(PG8_SB(1, 1), cB + hstepB + kstep, voffB);
        PG8_WAIT_V(6); PG8_BAR;
    } else {
        PG8_STAGE(PG8_SB(0, 0), cB, voffB); PG8_STAGE(PG8_SA(0, 0), cA, voffA); PG8_STAGE(PG8_SB(0, 1), cB + hstepB, voffB); PG8_STAGE(PG8_SA(0, 1), cA + hstepA, voffA);
        if (wr == 1) PG8_BAR;
        PG8_WAIT_V(4); PG8_BAR;
        PG8_STAGE(PG8_SB(1, 0), cB + kstep, voffB); PG8_STAGE(PG8_SA(1, 0), cA + kstep, voffA); PG8_STAGE(PG8_SB(1, 1), cB + hstepB + kstep, voffB);
        PG8_WAIT_V(6); PG8_BAR;
    }
    for (;;) {
        const bool has_next = S.next(ui + 1, nxt);
        const char* nA = has_next ? (const char*)((Epi::MULTI && nxt.part) ? g.A2 : g.A) + (size_t)nxt.pm * tstepA : cA; const char* nB = has_next ? (const char*)((Epi::MULTI && nxt.part) ? g.Bt2 : g.Bt) + (size_t)nxt.pn * tstepB : cB;
        for (int t = 0; t < nt; t += 2) {
            const bool last = (t == nt - 2);
            const char* a1 = cA + (size_t)(t + 1) * kstep;
            const char* a2 = last ? nA : cA + (size_t)(t + 2) * kstep; const char* b2 = last ? nB : cB + (size_t)(t + 2) * kstep;
            const char* a3 = a2 + kstep; const char* b3 = b2 + kstep;
            if (last && has_next) S.a_ready(nxt);
            if constexpr (SP2) {
            PG8_LDB(B0, 0, 0); PG8_LDB(B1, 0, 1); PG8_SCHED; PG8_LDA(At, 0, 0); PG8_STAGE(PG8_SA(1, 1), a1 + hstepA, voffA);
            PG8_WAIT_V(8); PG8_WAIT_L(0); PG8_BAR; PG8_MMA(0, 0, At, B0); PG8_MMA(0, 1, At, B1); PG8_BAR; PG8_SCHED;
            PG8_LDA(At, 0, 1); PG8_STAGE(PG8_SB(0, 0), b2, voffB); PG8_STAGE(PG8_SB(0, 1), b2 + hstepB, voffB); PG8_STAGE(PG8_SA(0, 0), a2, voffA);
            PG8_WAIT_V(8); PG8_WAIT_L(0); PG8_BAR; PG8_MMA(1, 0, At, B0); PG8_MMA(1, 1, At, B1); PG8_BAR; PG8_SCHED;
            PG8_LDB(B0, 1, 0); PG8_LDB(B1, 1, 1); PG8_SCHED; PG8_LDA(At, 1, 0); PG8_STAGE(PG8_SA(0, 1), a2 + hstepA, voffA);
            PG8_WAIT_V(8); PG8_WAIT_L(0); PG8_BAR; PG8_MMA(0, 0, At, B0); PG8_MMA(0, 1, At, B1); PG8_BAR; PG8_SCHED;
            PG8_LDA(At, 1, 1); PG8_STAGE(PG8_SB(1, 0), b3, voffB); PG8_STAGE(PG8_SB(1, 1), b3 + hstepB, voffB); PG8_STAGE(PG8_SA(1, 0), a3, voffA);
            PG8_WAIT_V(8); PG8_WAIT_L(0); PG8_BAR; PG8_MMA(1, 0, At, B0); PG8_MMA(1, 1, At, B1); PG8_BAR; PG8_SCHED;
            } else {
            PG8_LDB(B0, 0, 0); PG8_SCHED; PG8_LDA(At, 0, 0); PG8_STAGE(PG8_SA(1, 1), a1 + hstepA, voffA);
            PG8_WAIT_L(8); PG8_BAR; PG8_WAIT_L(0); PG8_MMA(0, 0, At, B0); PG8_BAR; PG8_SCHED;
            PG8_LDB(B1, 0, 1); PG8_STAGE(PG8_SB(0, 0), b2, voffB);
            PG8_BAR; PG8_WAIT_L(0); PG8_MMA(0, 1, At, B1); PG8_BAR;
            PG8_LDA(At, 0, 1); PG8_STAGE(PG8_SA(0, 0), a2, voffA);
            PG8_BAR; PG8_WAIT_L(0); PG8_MMA(1, 0, At, B0); PG8_BAR; PG8_SCHED;
            PG8_STAGE(PG8_SB(0, 1), b2 + hstepB, voffB);
            PG8_WAIT_V(6); PG8_BAR; PG8_MMA(1, 1, At, B1); PG8_BAR;
            PG8_LDB(B0, 1, 0); PG8_SCHED; PG8_LDA(At, 1, 0); PG8_STAGE(PG8_SA(0, 1), a2 + hstepA, voffA);
            PG8_WAIT_L(8); PG8_BAR; PG8_WAIT_L(0); PG8_MMA(0, 0, At, B0); PG8_BAR; PG8_SCHED;
            PG8_LDB(B1, 1, 1); PG8_STAGE(PG8_SB(1, 0), b3, voffB);
            PG8_BAR; PG8_WAIT_L(0); PG8_MMA(0, 1, At, B1); PG8_BAR;
            PG8_LDA(At, 1, 1); PG8_STAGE(PG8_SA(1, 0), a3, voffA);
            PG8_BAR; PG8_WAIT_L(0); PG8_MMA(1, 0, At, B0); PG8_BAR; PG8_SCHED;
            PG8_STAGE(PG8_SB(1, 1), b3 + hstepB, voffB);
            PG8_WAIT_V(6); PG8_BAR; PG8_MMA(1, 1, At, B1); PG8_BAR;
            }
        }
        if constexpr (ALIGN_EPI) { if (wr == 0) PG8_BAR; }
        bool keep_acc_ = false;
        if constexpr (Epi::DUAL) { if (cur.part == 0) { E.mid(acc, cur, wr, wc, fr, fq); keep_acc_ = true; } else { E(acc, cur, wr, wc, fr, fq); } S.done(cur); }
        else if constexpr (!Epi::AFTER_DRAIN) { E(acc, cur, wr, wc, fr, fq); S.done(cur); }
        if (!has_next) break;
        if (!keep_acc_)
#pragma unroll
        for (int a = 0; a < 2; ++a)
#pragma unroll
            for (int b = 0; b < 2; ++b)
#pragma unroll
                for (int m = 0; m < 4; ++m)
#pragma unroll
                    for (int n = 0; n < 2; ++n) acc[a][b][m][n] = (f32x4){0.f, 0.f, 0.f, 0.f};
        cur = nxt; cA = nA; cB = nB; ++ui;
        if constexpr (ALIGN_EPI) { if (wr == 1) PG8_BAR; }
    }
    PG8_WAIT_V(0);
    if constexpr (!ALIGN_EPI) { if (wr == 0) PG8_BAR; }
    PG8_BAR;
    if constexpr (Epi::AFTER_DRAIN) { E.fused(acc, cur, wr, wc, fr, fq, lds, wid, lane); S.done(cur); }
#undef PG8_SA
#undef PG8_SB
#undef PG8_STAGE
#undef PG8_LDA
#undef PG8_LDB
#undef PG8_MMA
#undef PG8_WAIT_V
#undef PG8_WAIT_L
#undef PG8_BAR
#undef PG8_SCHED
}
}
namespace pg8 {
typedef unsigned u32x2 __attribute__((ext_vector_type(2)));
__device__ __forceinline__ float bf_lo(unsigned w) { return __builtin_bit_cast(float, w << 16); }
__device__ __forceinline__ float bf_hi(unsigned w) { return __builtin_bit_cast(float, w & 0xffff0000u); }
__device__ __forceinline__ float sigmoidf_fast(float x) { return __builtin_amdgcn_rcpf(1.0f + __builtin_amdgcn_exp2f(-1.4426950408889634f * x)); }
template <int MODE> struct EpiB {
    static constexpr bool DUAL = false, MULTI = false; static constexpr bool PERM = true, AFTER_DRAIN = false;
    bf16_t* O; int ldc; const float* bias; int bias_skip_tile, bias_skip; const bf16_t* gate; int ldg;
    __device__ __forceinline__ void operator()(const f32x4 (&acc)[2][2][4][2], const Unit& u, int wr, int wc, int fr, int fq) const {
        const int row0 = u.pm * BM + wr * 64 + fr; const int col0 = u.pn * BM + wc * 32 + 8 * fq;
        f32x4 bv[2][2];
        if (MODE == 0) { const int bcol0 = col0 + (u.pn >= bias_skip_tile ? bias_skip : 0);
#pragma unroll
            for (int bj = 0; bj < 2; ++bj)
#pragma unroll
                for (int n = 0; n < 2; ++n) bv[bj][n] = *(const f32x4*)(bias + bcol0 + bj * HALF + 4 * n); }
#pragma unroll
        for (int ai = 0; ai < 2; ++ai)
#pragma unroll
            for (int m = 0; m < 4; ++m) { const int row = row0 + ai * HALF + m * 16; bf16_t* rowp = O + (size_t)row * ldc + col0;
                float rb = 0.f; if (MODE == 1) rb = bias[row];
#pragma unroll
                for (int bj = 0; bj < 2; ++bj) { f32x4 v0 = acc[ai][bj][m][0], v1 = acc[ai][bj][m][1];
                    if (MODE == 0) { v0 = v0 + bv[bj][0]; v1 = v1 + bv[bj][1]; }
                    if (MODE == 1) { v0 = v0 + rb; v1 = v1 + rb; }
                    if (MODE == 2 || MODE == 3) { const u32x4 gw = *(const u32x4*)(gate + (size_t)row * ldg + col0 + bj * HALF);
                        v0[0] *= sigmoidf_fast(bf_lo(gw.x)); v0[1] *= sigmoidf_fast(bf_hi(gw.x)); v0[2] *= sigmoidf_fast(bf_lo(gw.y)); v0[3] *= sigmoidf_fast(bf_hi(gw.y));
                        v1[0] *= sigmoidf_fast(bf_lo(gw.z)); v1[1] *= sigmoidf_fast(bf_hi(gw.z)); v1[2] *= sigmoidf_fast(bf_lo(gw.w)); v1[3] *= sigmoidf_fast(bf_hi(gw.w)); }
                    if (MODE == 3) { const u32x4 pw = *(const u32x4*)(rowp + bj * HALF);
                        v0[0] += bf_lo(pw.x); v0[1] += bf_hi(pw.x); v0[2] += bf_lo(pw.y); v0[3] += bf_hi(pw.y);
                        v1[0] += bf_lo(pw.z); v1[1] += bf_hi(pw.z); v1[2] += bf_lo(pw.w); v1[3] += bf_hi(pw.w); }
                    u32x4 w; w.x = cvt_pk_bf16(v0[0], v0[1]); w.y = cvt_pk_bf16(v0[2], v0[3]); w.z = cvt_pk_bf16(v1[0], v1[1]); w.w = cvt_pk_bf16(v1[2], v1[3]);
                    *(u32x4*)(rowp + bj * HALF) = w; } }
    }
};
template <bool ACCUM> struct EpiGate {
    static constexpr bool DUAL = false, MULTI = false; static constexpr bool PERM = true, AFTER_DRAIN = false;
    bf16_t* O; int ldc; const bf16_t* gate; int ldg;
    __device__ __forceinline__ void operator()(const f32x4 (&acc)[2][2][4][2], const Unit& u, int wr, int wc, int fr, int fq) const {
        const int row0 = u.pm * BM + wr * 64 + fr; const int col0 = u.pn * BM + wc * 32 + 8 * fq;
        u32x4 gw[3][2], pw[3][2];
#define EG_LOAD(gg) do { const int rw_ = row0 + ((gg) >> 2) * HALF + ((gg) & 3) * 16; \
            _Pragma("unroll") for (int bj = 0; bj < 2; ++bj) { gw[(gg) % 3][bj] = *(const u32x4*)(gate + (size_t)rw_ * ldg + col0 + bj * HALF); if (ACCUM) pw[(gg) % 3][bj] = *(const u32x4*)(O + (size_t)rw_ * ldc + col0 + bj * HALF); } } while (0)
        EG_LOAD(0); EG_LOAD(1);
#pragma unroll
        for (int g = 0; g < 8; ++g) { const int ai = g >> 2, m = g & 3; const int row = row0 + ai * HALF + m * 16; bf16_t* rowp = O + (size_t)row * ldc + col0;
            if (g + 2 < 8) EG_LOAD(g + 2);
#pragma unroll
            for (int bj = 0; bj < 2; ++bj) { f32x4 v0 = acc[ai][bj][m][0], v1 = acc[ai][bj][m][1]; const u32x4 q = gw[g % 3][bj];
                v0[0] *= sigmoidf_fast(bf_lo(q.x)); v0[1] *= sigmoidf_fast(bf_hi(q.x)); v0[2] *= sigmoidf_fast(bf_lo(q.y)); v0[3] *= sigmoidf_fast(bf_hi(q.y));
                v1[0] *= sigmoidf_fast(bf_lo(q.z)); v1[1] *= sigmoidf_fast(bf_hi(q.z)); v1[2] *= sigmoidf_fast(bf_lo(q.w)); v1[3] *= sigmoidf_fast(bf_hi(q.w));
                if (ACCUM) { const u32x4 p = pw[g % 3][bj];
                    v0[0] += bf_lo(p.x); v0[1] += bf_hi(p.x); v0[2] += bf_lo(p.y); v0[3] += bf_hi(p.y); v1[0] += bf_lo(p.z); v1[1] += bf_hi(p.z); v1[2] += bf_lo(p.w); v1[3] += bf_hi(p.w); }
                u32x4 w; w.x = cvt_pk_bf16(v0[0], v0[1]); w.y = cvt_pk_bf16(v0[2], v0[3]); w.z = cvt_pk_bf16(v1[0], v1[1]); w.w = cvt_pk_bf16(v1[2], v1[3]);
                *(u32x4*)(rowp + bj * HALF) = w; } }
#undef EG_LOAD
    }
};
struct EpiGateDual {
    static constexpr bool DUAL = true, MULTI = true; static constexpr bool PERM = true, AFTER_DRAIN = false;
    bf16_t* O; int ldc; const bf16_t* ga; const bf16_t* gc; int ldg;
    static __device__ __forceinline__ float em(float x) { return __builtin_amdgcn_exp2f(-1.4426950408889634f * x); }
    __device__ __forceinline__ void mid(f32x4 (&acc)[2][2][4][2], const Unit& u, int wr, int wc, int fr, int fq) const {
        const int row0 = u.pm * BM + wr * 64 + fr; const int col0 = u.pn * BM + wc * 32 + 8 * fq;
        u32x4 qa[3][2], qc[3][2];
#define EGD_LOAD(gg) do { const int rw_ = row0 + ((gg) >> 2) * HALF + ((gg) & 3) * 16; \
            _Pragma("unroll") for (int bj = 0; bj < 2; ++bj) { qa[(gg) % 3][bj] = *(const u32x4*)(ga + (size_t)rw_ * ldg + col0 + bj * HALF); qc[(gg) % 3][bj] = *(const u32x4*)(gc + (size_t)rw_ * ldg + col0 + bj * HALF); } } while (0)
        EGD_LOAD(0); EGD_LOAD(1);
#pragma unroll
        for (int g = 0; g < 8; ++g) { const int ai = g >> 2, m = g & 3;
            if (g + 2 < 8) EGD_LOAD(g + 2);
#pragma unroll
            for (int bj = 0; bj < 2; ++bj) { const u32x4 a = qa[g % 3][bj], c = qc[g % 3][bj];
#define EGD_R(av, cv) ((1.0f + em(cv)) * __builtin_amdgcn_rcpf(1.0f + em(av)))
                acc[ai][bj][m][0][0] *= EGD_R(bf_lo(a.x), bf_lo(c.x)); acc[ai][bj][m][0][1] *= EGD_R(bf_hi(a.x), bf_hi(c.x)); acc[ai][bj][m][0][2] *= EGD_R(bf_lo(a.y), bf_lo(c.y)); acc[ai][bj][m][0][3] *= EGD_R(bf_hi(a.y), bf_hi(c.y));
                acc[ai][bj][m][1][0] *= EGD_R(bf_lo(a.z), bf_lo(c.z)); acc[ai][bj][m][1][1] *= EGD_R(bf_hi(a.z), bf_hi(c.z)); acc[ai][bj][m][1][2] *= EGD_R(bf_lo(a.w), bf_lo(c.w)); acc[ai][bj][m][1][3] *= EGD_R(bf_hi(a.w), bf_hi(c.w));
#undef EGD_R
            } }
#undef EGD_LOAD
    }
    __device__ __forceinline__ void operator()(const f32x4 (&acc)[2][2][4][2], const Unit& u, int wr, int wc, int fr, int fq) const {
        const int row0 = u.pm * BM + wr * 64 + fr; const int col0 = u.pn * BM + wc * 32 + 8 * fq;
        u32x4 qc[3][2];
#define EGD_LOAD(gg) do { const int rw_ = row0 + ((gg) >> 2) * HALF + ((gg) & 3) * 16; \
            _Pragma("unroll") for (int bj = 0; bj < 2; ++bj) qc[(gg) % 3][bj] = *(const u32x4*)(gc + (size_t)rw_ * ldg + col0 + bj * HALF); } while (0)
        EGD_LOAD(0); EGD_LOAD(1);
#pragma unroll
        for (int g = 0; g < 8; ++g) { const int ai = g >> 2, m = g & 3; const int row = row0 + ai * HALF + m * 16; bf16_t* rowp = O + (size_t)row * ldc + col0;
            if (g + 2 < 8) EGD_LOAD(g + 2);
#pragma unroll
            for (int bj = 0; bj < 2; ++bj) { f32x4 v0 = acc[ai][bj][m][0], v1 = acc[ai][bj][m][1]; const u32x4 q = qc[g % 3][bj];
                v0[0] *= sigmoidf_fast(bf_lo(q.x)); v0[1] *= sigmoidf_fast(bf_hi(q.x)); v0[2] *= sigmoidf_fast(bf_lo(q.y)); v0[3] *= sigmoidf_fast(bf_hi(q.y));
                v1[0] *= sigmoidf_fast(bf_lo(q.z)); v1[1] *= sigmoidf_fast(bf_hi(q.z)); v1[2] *= sigmoidf_fast(bf_lo(q.w)); v1[3] *= sigmoidf_fast(bf_hi(q.w));
                u32x4 w; w.x = cvt_pk_bf16(v0[0], v0[1]); w.y = cvt_pk_bf16(v0[2], v0[3]); w.z = cvt_pk_bf16(v1[0], v1[1]); w.w = cvt_pk_bf16(v1[2], v1[3]);
                *(u32x4*)(rowp + bj * HALF) = w; } }
#undef EGD_LOAD
    }
};
struct PairedOrder {
    StaticOrder so;
    __host__ __device__ void init(int M, int N, int G_, int c_) { so.init(M, N, G_, c_); }
    __host__ __device__ bool next(int i, Unit& u) const { const bool ok = so.next(i >> 1, u); u.part = i & 1; return ok; }
    __device__ __forceinline__ void a_ready(const Unit&) const {}
    __device__ __forceinline__ void done(const Unit&) const {}
};
struct EpiRes {
    static constexpr bool DUAL = false, MULTI = false; static constexpr bool PERM = false, AFTER_DRAIN = false;
    const float* base; float* out; int ldc; const float* bias; float alpha;
    __device__ __forceinline__ void operator()(const f32x4 (&acc)[2][2][4][2], const Unit& u, int wr, int wc, int fr, int fq) const {
        const int col0 = u.pn * BM + wc * 32 + 4 * fq;
        f32x4 bv[2][2];
#pragma unroll
        for (int bj = 0; bj < 2; ++bj)
#pragma unroll
            for (int n = 0; n < 2; ++n) bv[bj][n] = *(const f32x4*)(bias + col0 + bj * HALF + n * 16);
#pragma unroll
        for (int ai = 0; ai < 2; ++ai)
#pragma unroll
            for (int m = 0; m < 4; ++m) { const size_t off = (size_t)(u.pm * BM + ai * HALF + wr * 64 + m * 16 + fr) * ldc + col0;
#pragma unroll
                for (int bj = 0; bj < 2; ++bj)
#pragma unroll
                    for (int n = 0; n < 2; ++n) { const f32x4 bs = *(const f32x4*)(base + off + bj * HALF + n * 16);
                        *(f32x4*)(out + off + bj * HALF + n * 16) = bs * alpha + acc[ai][bj][m][n] + bv[bj][n]; } }
    }
};

__device__ __forceinline__ void stats_mr(const f32x2 s, float& mu, float& r) { mu = s.x * (1.0f / 1024.0f); const float var = s.y * (1.0f / 1024.0f) - mu * mu; r = __builtin_amdgcn_rsqf(var + 1e-5f); }
struct EpiLN {
    static constexpr bool DUAL = false, MULTI = false; static constexpr bool PERM = true, AFTER_DRAIN = false;
    bf16_t* O; int ldc; const float* cs; const float* bc; int skip_tile, skip; const float* stats;
    __device__ __forceinline__ void operator()(const f32x4 (&acc)[2][2][4][2], const Unit& u, int wr, int wc, int fr, int fq) const {
        const int row0 = u.pm * BM + wr * 64 + fr; const int col0 = u.pn * BM + wc * 32 + 8 * fq; const int bcol0 = col0 + (u.pn >= skip_tile ? skip : 0);
        f32x2 sv[2][4];
#pragma unroll
        for (int ai = 0; ai < 2; ++ai)
#pragma unroll
            for (int m = 0; m < 4; ++m) sv[ai][m] = *(const f32x2*)(stats + 2 * (size_t)(row0 + ai * HALF + m * 16));
        f32x4 cv[2][2], bv[2][2];
#pragma unroll
        for (int bj = 0; bj < 2; ++bj)
#pragma unroll
            for (int n = 0; n < 2; ++n) { cv[bj][n] = *(const f32x4*)(cs + bcol0 + bj * HALF + 4 * n); bv[bj][n] = *(const f32x4*)(bc + bcol0 + bj * HALF + 4 * n); }
#pragma unroll
        for (int ai = 0; ai < 2; ++ai)
#pragma unroll
            for (int m = 0; m < 4; ++m) { const int row = row0 + ai * HALF + m * 16; bf16_t* rowp = O + (size_t)row * ldc + col0;
                float mu, r; stats_mr(sv[ai][m], mu, r);
#pragma unroll
                for (int bj = 0; bj < 2; ++bj) { const f32x4 v0 = (acc[ai][bj][m][0] - cv[bj][0] * mu) * r + bv[bj][0], v1 = (acc[ai][bj][m][1] - cv[bj][1] * mu) * r + bv[bj][1];
                    u32x4 w; w.x = cvt_pk_bf16(v0[0], v0[1]); w.y = cvt_pk_bf16(v0[2], v0[3]); w.z = cvt_pk_bf16(v1[0], v1[1]); w.w = cvt_pk_bf16(v1[2], v1[3]);
                    *(u32x4*)(rowp + bj * HALF) = w; } }
    }
};
struct EpiLNP1 {
    static constexpr bool DUAL = false, MULTI = false; static constexpr bool PERM = true, AFTER_DRAIN = false;
    bf16_t* O; int ldc; const float* cs; const float* bc; const float* stats;
    __device__ __forceinline__ void operator()(const f32x4 (&acc)[2][2][4][2], const Unit& u, int wr, int wc, int fr, int fq) const {
        const int row0 = u.pm * BM + wr * 64 + fr; const int lc = wc * 32 + 8 * fq; const int pn = u.pn; const bool pair = (pn >= 4) && (pn < 8);
        int src0, src1, dst0;
        if (pn < 4) { src0 = 256 * pn; src1 = src0 + 128; dst0 = src0; }
        else if (pn < 8) { src0 = 1536 + 128 * (pn - 4); src1 = 2560 + 128 * (pn - 4); dst0 = 1024 + 128 * (pn - 4); }
        else if (pn < 10) { src0 = 2048 + 256 * (pn - 8); src1 = src0 + 128; dst0 = 1536 + 256 * (pn - 8); }
        else { src0 = 256 * pn + 512; src1 = src0 + 128; dst0 = 256 * pn; }
        f32x2 sv[2][4];
#pragma unroll
        for (int ai = 0; ai < 2; ++ai)
#pragma unroll
            for (int m = 0; m < 4; ++m) sv[ai][m] = *(const f32x2*)(stats + 2 * (size_t)(row0 + ai * HALF + m * 16));
        f32x4 cv[2][2], bv[2][2];
#pragma unroll
        for (int n = 0; n < 2; ++n) { cv[0][n] = *(const f32x4*)(cs + src0 + lc + 4 * n); bv[0][n] = *(const f32x4*)(bc + src0 + lc + 4 * n);
            cv[1][n] = *(const f32x4*)(cs + src1 + lc + 4 * n); bv[1][n] = *(const f32x4*)(bc + src1 + lc + 4 * n); }
#pragma unroll
        for (int ai = 0; ai < 2; ++ai)
#pragma unroll
            for (int m = 0; m < 4; ++m) { const int row = row0 + ai * HALF + m * 16; bf16_t* rowp = O + (size_t)row * ldc + dst0 + lc;
                float mu, r; stats_mr(sv[ai][m], mu, r);
                const f32x4 a0 = (acc[ai][0][m][0] - cv[0][0] * mu) * r + bv[0][0], a1 = (acc[ai][0][m][1] - cv[0][1] * mu) * r + bv[0][1];
                const f32x4 b0 = (acc[ai][1][m][0] - cv[1][0] * mu) * r + bv[1][0], b1 = (acc[ai][1][m][1] - cv[1][1] * mu) * r + bv[1][1];
                if (pair) { const f32x4 p0 = a0 * b0, p1 = a1 * b1;
                    u32x4 w; w.x = cvt_pk_bf16(p0[0], p0[1]); w.y = cvt_pk_bf16(p0[2], p0[3]); w.z = cvt_pk_bf16(p1[0], p1[1]); w.w = cvt_pk_bf16(p1[2], p1[3]);
                    *(u32x4*)(rowp) = w; }
                else { u32x4 w; w.x = cvt_pk_bf16(a0[0], a0[1]); w.y = cvt_pk_bf16(a0[2], a0[3]); w.z = cvt_pk_bf16(a1[0], a1[1]); w.w = cvt_pk_bf16(a1[2], a1[3]);
                    *(u32x4*)(rowp) = w;
                    u32x4 x; x.x = cvt_pk_bf16(b0[0], b0[1]); x.y = cvt_pk_bf16(b0[2], b0[3]); x.z = cvt_pk_bf16(b1[0], b1[1]); x.w = cvt_pk_bf16(b1[2], b1[3]);
                    *(u32x4*)(rowp + HALF) = x; } }
    }
};
struct EpiLNT {
    static constexpr bool DUAL = false, MULTI = false; static constexpr bool PERM = true, AFTER_DRAIN = false;
    bf16_t* O; int ldc; const float* cs; const float* bc; const float* stats;
    __device__ __forceinline__ void operator()(const f32x4 (&acc)[2][2][4][2], const Unit& u, int wr, int wc, int fr, int fq) const {
        const int row0 = u.pm * BM + wr * 64 + fr; const int col0 = u.pn * BM + wc * 32 + 8 * fq;
        f32x4 sq[2][4]; float cr[2][4], br[2][4];
#pragma unroll
        for (int bj = 0; bj < 2; ++bj)
#pragma unroll
            for (int q = 0; q < 4; ++q) sq[bj][q] = *(const f32x4*)(stats + 2 * (size_t)(col0 + bj * HALF) + 4 * q);
#pragma unroll
        for (int ai = 0; ai < 2; ++ai)
#pragma unroll
            for (int m = 0; m < 4; ++m) { cr[ai][m] = cs[row0 + ai * HALF + m * 16]; br[ai][m] = bc[row0 + ai * HALF + m * 16]; }
        float mu[2][8], r[2][8];
#pragma unroll
        for (int bj = 0; bj < 2; ++bj)
#pragma unroll
            for (int q = 0; q < 4; ++q) { stats_mr((f32x2){sq[bj][q][0], sq[bj][q][1]}, mu[bj][2 * q], r[bj][2 * q]); stats_mr((f32x2){sq[bj][q][2], sq[bj][q][3]}, mu[bj][2 * q + 1], r[bj][2 * q + 1]); }
#pragma unroll
        for (int ai = 0; ai < 2; ++ai)
#pragma unroll
            for (int m = 0; m < 4; ++m) { const int row = row0 + ai * HALF + m * 16; bf16_t* rowp = O + (size_t)row * ldc + col0; const float c = cr[ai][m], b = br[ai][m];
#pragma unroll
                for (int bj = 0; bj < 2; ++bj) { float v[8];
#pragma unroll
                    for (int e = 0; e < 8; ++e) v[e] = (acc[ai][bj][m][e >> 2][e & 3] - c * mu[bj][e]) * r[bj][e] + b;
                    u32x4 w; w.x = cvt_pk_bf16(v[0], v[1]); w.y = cvt_pk_bf16(v[2], v[3]); w.z = cvt_pk_bf16(v[4], v[5]); w.w = cvt_pk_bf16(v[6], v[7]);
                    *(u32x4*)(rowp + bj * HALF) = w; } }
    }
};
struct EpiRes2 {
    static constexpr bool DUAL = false, MULTI = false; static constexpr bool PERM = true, AFTER_DRAIN = false;
    const float* base; float* out; bf16_t* zb; int ldc; const float* bias; const float* bstats; const float* bg; const float* bb; float* ostats;
    __device__ __forceinline__ void operator()(const f32x4 (&acc)[2][2][4][2], const Unit& u, int wr, int wc, int fr, int fq) const {
        constexpr float alpha = 1.41421356237309515f;
        const int urow = u.pm * BM + wr * 64, ucol = u.pn * BM + wc * 32;
        const size_t ubase = (size_t)urow * ldc + ucol;
        const char* bp = (const char*)(base + ubase); char* op = (char*)(out + ubase); char* zp = (char*)(zb + ubase);
        const char* sp = (const char*)(bstats + 2 * (size_t)urow); float* osp = ostats + 2 * (size_t)urow;
        const unsigned l4 = (unsigned)(fr * ldc + 8 * fq) * 4u, l2 = (unsigned)(fr * ldc + 8 * fq) * 2u, ls = (unsigned)fr * 8u;
        const int col0 = ucol + 8 * fq;
        f32x4 gv[2][2], cv[2][2];
#pragma unroll
        for (int bj = 0; bj < 2; ++bj)
#pragma unroll
            for (int n = 0; n < 2; ++n) { gv[bj][n] = *(const f32x4*)(bg + col0 + bj * HALF + 4 * n) * alpha;
                cv[bj][n] = *(const f32x4*)(bb + col0 + bj * HALF + 4 * n) * alpha + *(const f32x4*)(bias + col0 + bj * HALF + 4 * n); }
        f32x2 sv_c = *(const f32x2*)(sp + ls);
        f32x4 p0 = *(const f32x4*)(bp + l4), p1 = *(const f32x4*)(bp + l4 + 16);
#pragma unroll
        for (int g = 0; g < 8; ++g) { const int ai = g >> 2, m = g & 3; const int rr = ai * HALF + m * 16, rn = ((g + 1) >> 2) * HALF + ((g + 1) & 3) * 16;
            f32x2 sv_n = sv_c; if (g + 1 < 8) sv_n = *(const f32x2*)(sp + (size_t)rn * 8 + ls);
            float mu, r; stats_mr(sv_c, mu, r); float s1 = 0.f, s2 = 0.f;
#pragma unroll
            for (int bj = 0; bj < 2; ++bj) { const size_t ro = (size_t)rr * ldc + bj * HALF;
                f32x4 q0 = p0, q1 = p1;
                if (bj == 0) { q0 = *(const f32x4*)(bp + (ro + HALF) * 4 + l4); q1 = *(const f32x4*)(bp + (ro + HALF) * 4 + l4 + 16); }
                else if (g + 1 < 8) { q0 = *(const f32x4*)(bp + (size_t)rn * ldc * 4 + l4); q1 = *(const f32x4*)(bp + (size_t)rn * ldc * 4 + l4 + 16); }
                const f32x4 z0 = gv[bj][0] * ((p0 - mu) * r) + acc[ai][bj][m][0] + cv[bj][0], z1 = gv[bj][1] * ((p1 - mu) * r) + acc[ai][bj][m][1] + cv[bj][1];
                *(f32x4*)(op + ro * 4 + l4) = z0; *(f32x4*)(op + ro * 4 + l4 + 16) = z1;
                s1 += ((z0[0] + z0[1]) + (z0[2] + z0[3])) + ((z1[0] + z1[1]) + (z1[2] + z1[3]));
                s2 += ((z0[0] * z0[0] + z0[1] * z0[1]) + (z0[2] * z0[2] + z0[3] * z0[3])) + ((z1[0] * z1[0] + z1[1] * z1[1]) + (z1[2] * z1[2] + z1[3] * z1[3]));
                if (zb) { u32x4 w; w.x = cvt_pk_bf16(z0[0], z0[1]); w.y = cvt_pk_bf16(z0[2], z0[3]); w.z = cvt_pk_bf16(z1[0], z1[1]); w.w = cvt_pk_bf16(z1[2], z1[3]); *(u32x4*)(zp + ro * 2 + l2) = w; }
                p0 = q0; p1 = q1; }
            s1 += __shfl_xor(s1, 16); s2 += __shfl_xor(s2, 16); s1 += __shfl_xor(s1, 32); s2 += __shfl_xor(s2, 32);
            if (fq == 0) { atomicAdd(osp + 2 * (rr + fr), s1); atomicAdd(osp + 2 * (rr + fr) + 1, s2); }
            sv_c = sv_n; }
    }
};
struct EpiP1Multi {
    static constexpr bool DUAL = false, MULTI = true; static constexpr bool PERM = true, AFTER_DRAIN = false;
    EpiLNP1 main; EpiLNT vt;
    __device__ __forceinline__ void operator()(const f32x4 (&acc)[2][2][4][2], const Unit& u, int wr, int wc, int fr, int fq) const {
        if (u.part == 0) main(acc, u, wr, wc, fr, fq); else vt(acc, u, wr, wc, fr, fq);
    }
};
struct P1Order {
    StaticOrder a, b; int n0, G, c;
    __host__ __device__ void init(int M0, int N0, int M1, int N1, int G_, int c_) { a.init(M0, N0, G_, c_); b.init(M1, N1, G_, c_); n0 = a.nwg; G = G_; c = c_; }
    __host__ __device__ bool next(int i, Unit& u) const {
        const long L = (long)i * G + c;
        if (L < n0) return a.at(L, u);
        const bool ok = b.at(L - n0, u); u.part = 1; return ok;
    }
    __device__ __forceinline__ void a_ready(const Unit&) const {}
    __device__ __forceinline__ void done(const Unit&) const {}
};
}
#define LAS __attribute__((address_space(3)))
typedef unsigned short bf16;
typedef unsigned v4u __attribute__((ext_vector_type(4)));
typedef unsigned v2u __attribute__((ext_vector_type(2)));
typedef float f32x4 __attribute__((ext_vector_type(4)));
typedef short bf16x8 __attribute__((ext_vector_type(8)));
constexpr int NWAVES = 8, NTHR = 512;
constexpr int DM = 1024, MC = 32768, NCHUNK = 3, NLAYER = 2;
constexpr int PW = 4608;
constexpr int AW = 512, DFF = 2816, NUP = 5632, PROJ_W = 5120;
constexpr int C_Q = 0, C_K = 512, C_GCU = 1024  , C_GB = 1536, C_GA = 2560, C_GCC = 3584;
constexpr float ALPHA = 1.41421356237309515f, LN_EPS = 1e-5f, LOG2E = 1.4426950408889634f;
constexpr size_t OFF_WIN = 0, OFF_WV = OFF_WIN + (size_t)PW * DM, OFF_WA = OFF_WV + (size_t)AW * DM, OFF_WC = OFF_WA + (size_t)DM * AW,
                 OFF_WO = OFF_WC + (size_t)DM * AW, OFF_WUP = OFF_WO + (size_t)DM * DM, OFF_WDN = OFF_WUP + (size_t)NUP * DM, W_LAYER = (size_t)16 << 20;
static_assert(OFF_WDN + (size_t)DM * DFF <= W_LAYER, "weights per layer");
constexpr size_t MiB = (size_t)1 << 20;
constexpr size_t WS_W = 0, WS_XB = 64 * MiB, WS_PROJ = 128 * MiB, WS_VT = 416 * MiB, WS_YA = 448 * MiB, WS_YC = 480 * MiB, WS_MG = 512 * MiB,
                 WS_H = 128 * MiB, WS_G = 576 * MiB, WS_ZERO = 752 * MiB, ZERO_BYTES = 4 * MiB, WS_ST = WS_ZERO, WS_CS = WS_ZERO + 3 * MiB, WS_BAR = WS_ZERO + 3 * MiB + 512 * 1024, WS_ID = 756 * MiB, WS_END = 757 * MiB;
constexpr int CS_IN = 0, BC_IN = 5120, CS_UP = 10240, BC_UP = 10240 + 5632, CS_LAYER = 10240 + 2 * 5632;
static_assert((size_t)NCHUNK * NLAYER * 2 * MC * 2 * 4 <= 3 * MiB && (size_t)NLAYER * CS_LAYER * 4 <= MiB, "zeroed region");
static_assert(WS_PROJ + (size_t)MC * PW * 2 <= WS_VT && WS_H + (size_t)MC * NUP * 2 <= WS_YC && WS_G + (size_t)MC * DFF * 2 <= WS_ZERO, "ws map");
constexpr int LDS_BYTES = 147456;

__device__ __forceinline__ unsigned f2bf(float f) { unsigned u = __builtin_bit_cast(unsigned, f); return (u + 0x7fffu + ((u >> 16) & 1u)) >> 16; }
__device__ __forceinline__ unsigned pk2(float lo, float hi) { return f2bf(lo) | (f2bf(hi) << 16); }
__device__ __forceinline__ float wave_sum(float v) {
#pragma unroll
    for (int o = 1; o < 64; o <<= 1) v += __shfl_xor(v, o);
    return v;
}
using pg8::bf_lo; using pg8::bf_hi; using pg8::cvt_pk_bf16;

__device__ __forceinline__ void transpose_item(const float* W, int K, int N, bf16* WT, int rowadj, LAS float* scr, int item, int lane,
                                               const float* gk, const float* bk, const float* bias, float* cs, float* bc) {
    const int nblk = N / 32, kb = item / nblk, nb = item % nblk, k0 = 64 * kb, n0 = 32 * nb;
    float pcs = 0.f, pbc = 0.f;
    float wl_[32];
#pragma unroll
    for (int i = 0; i < 32; ++i) wl_[i] = __builtin_nontemporal_load(W + (size_t)(k0 + 2 * i + (lane >> 5)) * N + n0 + (lane & 31));
#pragma unroll
    for (int i = 0; i < 32; ++i) { const int kk = 2 * i + (lane >> 5); const float w = wl_[i];
        float wg = w; if (gk) wg = w * gk[k0 + kk]; scr[kk * 33 + (lane & 31)] = wg;
        if (cs) { pcs += __builtin_bit_cast(float, f2bf(wg) << 16); if (bk) pbc += bk[k0 + kk] * w; } }
    if (cs) { pcs += __shfl_xor(pcs, 32); pbc += __shfl_xor(pbc, 32); if (kb == 0) pbc += bias[n0 + (lane & 31)];
        if (lane < 32) { atomicAdd(cs + n0 + lane, pcs); atomicAdd(bc + n0 + lane, pbc); } }
    asm volatile("s_waitcnt lgkmcnt(0)" ::: "memory");
    const int c = lane & 7;
#pragma unroll
    for (int j = 0; j < 4; ++j) { const int n = (lane >> 3) + 8 * j; const LAS float* s = scr + (8 * c) * 33 + n;
        v4u o; o.x = pk2(s[0 * 33], s[1 * 33]); o.y = pk2(s[2 * 33], s[3 * 33]); o.z = pk2(s[4 * 33], s[5 * 33]); o.w = pk2(s[6 * 33], s[7 * 33]);
        *(v4u*)(WT + (size_t)(n0 + n + rowadj) * K + k0 + 8 * c) = o; }
    asm volatile("s_waitcnt lgkmcnt(0)" ::: "memory");
}

__device__ __forceinline__ const float* idptr(const unsigned char* ws, int off) { asm volatile("" : "+s"(off)); return (const float*)(ws + WS_ID) + off; }
struct Args { const float* in[21]; float* out; unsigned char* ws; int ph_lo, ph_hi; };
__device__ __forceinline__ const float* ldin(const Args& a, int i) { asm volatile("" : "+s"(i)); return a.in[i]; }

__device__ __forceinline__ void prologue_weights(const Args& a, LAS unsigned char* lds, int gw, int NGW, int wave, int lane) {
    LAS float* scr = (LAS float*)(lds + wave * 16384);
    constexpr int I_IN = (DM / 64) * (PROJ_W / 32), I_BR = (AW / 64) * (DM / 32), I_O = (DM / 64) * (DM / 32), I_UP = (DM / 64) * (NUP / 32), I_DN = (DFF / 64) * (DM / 32);
    constexpr int PER_LAYER = I_IN + 2 * I_BR + I_O + I_UP + I_DN;
    for (int it = gw; it < NLAYER * PER_LAYER; it += NGW) {
        const int l = it / PER_LAYER; int r = it % PER_LAYER;
        bf16* wl = (bf16*)(a.ws + WS_W) + (size_t)l * W_LAYER;
        float* csl = (float*)(a.ws + WS_CS) + (size_t)l * CS_LAYER;
        if (r < I_IN) { const int nb = r % (PROJ_W / 32), n0 = nb * 32; const float* W = ldin(a, 2) + (size_t)l * DM * PROJ_W;
            const float* gk = l > 0 ? ldin(a, 19) + (size_t)(l - 1) * DM : nullptr; const float* bk = l > 0 ? ldin(a, 20) + (size_t)(l - 1) * DM : nullptr;
            bf16* dst = (n0 >= 1024 && n0 < 1536) ? wl + OFF_WV : wl + OFF_WIN; int adj;
            if (n0 < 1024) adj = 0; else if (n0 < 1536) adj = -1024;
            else if (n0 < 2048) { const int j = (n0 - 1536) >> 7; adj = (1024 + 256 * j + ((n0 - 1536) & 127)) - n0; }
            else if (n0 < 2560) adj = 0;
            else if (n0 < 3072) { const int j = (n0 - 2560) >> 7; adj = (1024 + 256 * j + 128 + ((n0 - 2560) & 127)) - n0; }
            else adj = -512;
            transpose_item(W, DM, PROJ_W, dst, adj, scr, r, lane, gk, bk, ldin(a, 3) + (size_t)l * PROJ_W, csl + CS_IN, csl + BC_IN);
            continue; } r -= I_IN;
        if (r < I_BR) { transpose_item(ldin(a, 7) + (size_t)l * AW * DM, AW, DM, wl + OFF_WA, 0, scr, r, lane, nullptr, nullptr, nullptr, nullptr, nullptr); continue; } r -= I_BR;
        if (r < I_BR) { transpose_item(ldin(a, 8) + (size_t)l * AW * DM, AW, DM, wl + OFF_WC, 0, scr, r, lane, nullptr, nullptr, nullptr, nullptr, nullptr); continue; } r -= I_BR;
        if (r < I_O) { transpose_item(ldin(a, 9) + (size_t)l * DM * DM, DM, DM, wl + OFF_WO, 0, scr, r, lane, nullptr, nullptr, nullptr, nullptr, nullptr); continue; } r -= I_O;
        if (r < I_UP) { transpose_item(ldin(a, 13) + (size_t)l * DM * NUP, DM, NUP, wl + OFF_WUP, 0, scr, r, lane, ldin(a, 11) + (size_t)l * DM, ldin(a, 12) + (size_t)l * DM,
                                       ldin(a, 14) + (size_t)l * NUP, csl + CS_UP, csl + BC_UP); continue; } r -= I_UP;
        transpose_item(ldin(a, 17) + (size_t)l * DFF * DM, DFF, DM, wl + OFF_WDN, 0, scr, r, lane, nullptr, nullptr, nullptr, nullptr, nullptr);
    }
}
__device__ __forceinline__ void convert_rows(const float* x, bf16* xb, int nrows, int vcu, int NGW) {
    int t_ = threadIdx.x; asm volatile("" : "+v"(t_)); const int lane = t_ & 63, gw = vcu * NWAVES + __builtin_amdgcn_readfirstlane(t_ >> 6);
    for (int m = gw * 4; m < nrows; m += NGW * 4) {
        f32x4 v[4][4];
#pragma unroll
        for (int q = 0; q < 4; ++q) { const f32x4* xr = (const f32x4*)(x + (size_t)(m + q) * DM) + lane;
#pragma unroll
            for (int j = 0; j < 4; ++j) v[q][j] = __builtin_nontemporal_load(xr + 64 * j); }
#pragma unroll
        for (int q = 0; q < 4; ++q) { v2u* o = (v2u*)(xb + (size_t)(m + q) * DM) + lane;
#pragma unroll
            for (int j = 0; j < 4; ++j) { v2u w; w.x = cvt_pk_bf16(v[q][j][0], v[q][j][1]); w.y = cvt_pk_bf16(v[q][j][2], v[q][j][3]); o[64 * j] = w; } }
    }
}
__device__ __forceinline__ void ln_rows(float* z, bf16* xb, const float* g, const float* b, int nrows, int vcu, int NGW, bool write_xb) {
    int t_ = threadIdx.x; asm volatile("" : "+v"(t_)); const int lane = t_ & 63, gw = vcu * NWAVES + __builtin_amdgcn_readfirstlane(t_ >> 6);
    f32x4 gv[4], bv[4];
#pragma unroll
    for (int j = 0; j < 4; ++j) { gv[j] = ((const f32x4*)g)[64 * j + lane]; bv[j] = ((const f32x4*)b)[64 * j + lane]; }
    for (int m = gw * 2; m < nrows; m += NGW * 2) {
        f32x4 v[2][4];
#pragma unroll
        for (int q = 0; q < 2; ++q) { const f32x4* xr = (const f32x4*)(z + (size_t)(m + q) * DM) + lane;
#pragma unroll
            for (int j = 0; j < 4; ++j) v[q][j] = xr[64 * j]; }
#pragma unroll
        for (int q = 0; q < 2; ++q) { f32x4* xr = (f32x4*)(z + (size_t)(m + q) * DM) + lane; v2u* o = (v2u*)(xb + (size_t)(m + q) * DM) + lane;
            float s = 0.f;
#pragma unroll
            for (int j = 0; j < 4; ++j) s += (v[q][j][0] + v[q][j][1]) + (v[q][j][2] + v[q][j][3]);
            const float mean = wave_sum(s) * (1.f / DM); float s2 = 0.f;
#pragma unroll
            for (int j = 0; j < 4; ++j) { v[q][j] = v[q][j] - mean; s2 += (v[q][j][0] * v[q][j][0] + v[q][j][1] * v[q][j][1]) + (v[q][j][2] * v[q][j][2] + v[q][j][3] * v[q][j][3]); }
            const float rstd = 1.f / sqrtf(wave_sum(s2) * (1.f / DM) + LN_EPS);
#pragma unroll
            for (int j = 0; j < 4; ++j) { const f32x4 y = v[q][j] * rstd * gv[j] + bv[j]; xr[64 * j] = y;
                if (write_xb) { v2u w; w.x = cvt_pk_bf16(y[0], y[1]); w.y = cvt_pk_bf16(y[2], y[3]); o[64 * j] = w; } } }
    }
}
__device__ __forceinline__ void unpack8(const v4u w, float (&f)[8]) {
    f[0] = bf_lo(w.x); f[1] = bf_hi(w.x); f[2] = bf_lo(w.y); f[3] = bf_hi(w.y); f[4] = bf_lo(w.z); f[5] = bf_hi(w.z); f[6] = bf_lo(w.w); f[7] = bf_hi(w.w);
}
__device__ __forceinline__ void convbranch_phase(const bf16* proj, bf16* yc, const float* cw, const float* cb, int T, int vcu, int NT) {
    int t_ = threadIdx.x; asm volatile("" : "+v"(t_)); const int gtid = vcu * NTHR + t_;
    constexpr int NG = AW / 8, L = 16, R = MC / L;
    for (int item = gtid; item < NG * R; item += NT) {
        const int run = item / NG, ch = (item - run * NG) * 8, t0 = run * L;
        float w0[8], w1[8], w2[8], bb[8];
#pragma unroll
        for (int e = 0; e < 8; e += 4) { *(f32x4*)(w0 + e) = *(const f32x4*)(cw + ch + e); *(f32x4*)(w1 + e) = *(const f32x4*)(cw + AW + ch + e);
            *(f32x4*)(w2 + e) = *(const f32x4*)(cw + 2 * AW + ch + e); *(f32x4*)(bb + e) = *(const f32x4*)(cb + ch + e); }
        const bf16* p = proj + (size_t)t0 * PW + ch;
        float pp[8], pc[8], fu[8], fc[8];
        unpack8(*(const v4u*)(p + C_GCU), pc);
        if (t0 > 0) unpack8(*(const v4u*)(p - PW + C_GCU), pp);
        else {
#pragma unroll
          for (int e = 0; e < 8; ++e) pp[e] = 0.f; }
        for (int t = t0; t < t0 + L; t += 4) {
            const v4u z4 = (v4u){0u, 0u, 0u, 0u}; v4u un[4], gq[4];
#pragma unroll
            for (int q = 0; q < 4; ++q) { un[q] = z4; gq[q] = *(const v4u*)(p + (size_t)q * PW + C_GB);
                if (t + q + 1 < MC) un[q] = *(const v4u*)(p + (size_t)(q + 1) * PW + C_GCU); }
#pragma unroll
            for (int q = 0; q < 4; ++q) { const int tpos = (t + q) & (T - 1);
                float fg[8], pn[8], r[8]; unpack8(gq[q], fg); unpack8(un[q], pn);
                const float mp = tpos == 0 ? 0.f : 1.f, mn = tpos == T - 1 ? 0.f : 1.f;
#pragma unroll
                for (int e = 0; e < 8; ++e) { r[e] = fg[e] * (w0[e] * (pp[e] * mp) + w1[e] * pc[e] + w2[e] * (pn[e] * mn) + bb[e]); pp[e] = pc[e]; pc[e] = pn[e]; }
                v4u o; o.x = cvt_pk_bf16(r[0], r[1]); o.y = cvt_pk_bf16(r[2], r[3]); o.z = cvt_pk_bf16(r[4], r[5]); o.w = cvt_pk_bf16(r[6], r[7]);
                *(v4u*)(yc + (size_t)(t + q) * AW + ch) = o; }
            p += 4 * (size_t)PW;
        }
    }
}
__device__ __forceinline__ float gelu_tanh(float x) {
    const float u = x * (0.7978845608028654f + 0.035677408136300125f * x * x);
    return x * __builtin_amdgcn_rcpf(1.0f + __builtin_amdgcn_exp2f(-2.0f * LOG2E * u));
}
__device__ __forceinline__ void ffnconv_phase(const bf16* h, bf16* gout, const float* cw, const float* cb, int T, int vcu, int NT) {
    int t_ = threadIdx.x; asm volatile("" : "+v"(t_)); const int gtid = vcu * NTHR + t_;
    constexpr int NG = DFF / 8, L = 96, R = (MC + L - 1) / L, RS = 8;
    static_assert(L % RS == 0 && MC % RS == 0, "rows are walked RS at a time");
    for (int item = gtid; item < NG * R; item += NT) {
        const int run = item / NG, ch = (item - run * NG) * 8, t0 = run * L, t1 = (t0 + L < MC) ? t0 + L : MC;
        float wg0[8], wg1[8], wg2[8], bg[8], wv0[8], wv1[8], wv2[8], bv[8];
#pragma unroll
        for (int e = 0; e < 8; e += 4) {
            *(f32x4*)(wg0 + e) = *(const f32x4*)(cw + ch + e); *(f32x4*)(wg1 + e) = *(const f32x4*)(cw + NUP + ch + e); *(f32x4*)(wg2 + e) = *(const f32x4*)(cw + 2 * NUP + ch + e); *(f32x4*)(bg + e) = *(const f32x4*)(cb + ch + e);
            *(f32x4*)(wv0 + e) = *(const f32x4*)(cw + DFF + ch + e); *(f32x4*)(wv1 + e) = *(const f32x4*)(cw + NUP + DFF + ch + e); *(f32x4*)(wv2 + e) = *(const f32x4*)(cw + 2 * NUP + DFF + ch + e); *(f32x4*)(bv + e) = *(const f32x4*)(cb + DFF + ch + e); }
        const bf16* p = h + (size_t)t0 * NUP + ch;
        const v4u z4 = (v4u){0u, 0u, 0u, 0u};
        v4u gp_ = z4, vp_ = z4, gc_ = *(const v4u*)(p), vc_ = *(const v4u*)(p + DFF);
        if (t0 > 0) { gp_ = *(const v4u*)(p - NUP); vp_ = *(const v4u*)(p - NUP + DFF); }
        for (int t = t0; t < t1; t += RS) {
            v4u gn_[RS], vn_[RS];
#pragma unroll
            for (int q = 0; q < RS; ++q) { gn_[q] = z4; vn_[q] = z4; if (t + q + 1 < MC) { gn_[q] = __builtin_nontemporal_load((const v4u*)(p + (size_t)(q + 1) * NUP)); vn_[q] = __builtin_nontemporal_load((const v4u*)(p + (size_t)(q + 1) * NUP + DFF)); } }
#pragma unroll
            for (int q = 0; q < RS; ++q) {
                const int tpos = (t + q) & (T - 1);
                const float mp = tpos == 0 ? 0.f : 1.f, mn = tpos == T - 1 ? 0.f : 1.f;
                float a0[8], a1[8], a2[8], b0[8], b1[8], b2[8], r[8];
                unpack8(gp_, a0); unpack8(gc_, a1); unpack8(gn_[q], a2); unpack8(vp_, b0); unpack8(vc_, b1); unpack8(vn_[q], b2);
#pragma unroll
                for (int e = 0; e < 8; ++e) { const float hg = wg0[e] * (a0[e] * mp) + wg1[e] * a1[e] + wg2[e] * (a2[e] * mn) + bg[e];
                    const float hv = wv0[e] * (b0[e] * mp) + wv1[e] * b1[e] + wv2[e] * (b2[e] * mn) + bv[e]; r[e] = gelu_tanh(hg) * hv; }
                v4u o; o.x = cvt_pk_bf16(r[0], r[1]); o.y = cvt_pk_bf16(r[2], r[3]); o.z = cvt_pk_bf16(r[4], r[5]); o.w = cvt_pk_bf16(r[6], r[7]);
                *(v4u*)(gout + (size_t)(t + q) * DFF + ch) = o;
                gp_ = gc_; gc_ = gn_[q]; vp_ = vc_; vc_ = vn_[q]; }
            p += RS * (size_t)NUP;
        }
    }
}
__device__ __forceinline__ void attn_phase(const bf16* __restrict__ proj, const bf16* __restrict__ vt, bf16* __restrict__ ya, const float* __restrict__ rpb, int T, int vcu, int G, LAS unsigned char* lds) {
    int t_ = threadIdx.x; asm volatile("" : "+v"(t_)); const int lane = t_ & 63, wave = __builtin_amdgcn_readfirstlane(t_ >> 6);
    LAS float* tbl = (LAS float*)lds;
    for (int idx = wave * 64 + lane; idx < 8 * 15 * 31; idx += NTHR) tbl[idx] = rpb[idx] * LOG2E;
    __syncthreads();
    const int rows = T >> 6, nrgp = rows >> 4;
    const int n = lane & 15, q4 = lane >> 4, c = wave & 3, q0 = c * 16, cs = (c == 0) ? 0 : (c == 1) ? 8 : (c == 2) ? 24 : 32;
    const float SC = 0.125f * LOG2E;
    const unsigned qlane = (unsigned)(n * PW + 8 * q4) * 2u, klane = (unsigned)((8 * (n >> 2) + (n & 3)) * PW + 8 * q4) * 2u, vlane = (unsigned)(n * MC + 8 * q4) * 2u, olane = (unsigned)(n * AW + 4 * q4) * 2u;
    unsigned dpack0 = 0u, dpack1 = 0u, vmask = 0u;
    { const int qj = q0 + n; int js = qj - 8; js = js < 0 ? 0 : js; js = js > 48 ? 48 : js;
#pragma unroll
      for (int hf = 0; hf < 2; ++hf)
#pragma unroll
          for (int j = 0; j < 4; ++j) { const int kj = cs + 8 * q4 + 4 * hf + j; const bool v = (kj >= js) && (kj < js + 16); int dc = kj - qj + 15; dc = dc < 0 ? 0 : dc; dc = dc > 30 ? 30 : dc;
              if (hf == 0) dpack0 |= (unsigned)dc << (8 * j); else dpack1 |= (unsigned)dc << (8 * j); vmask |= (v ? 1u : 0u) << (hf * 4 + j); } }
    asm volatile("" : "+v"(dpack0), "+v"(dpack1), "+v"(vmask));
    for (int wt = vcu; wt < 256; wt += G) {
        const int rgp = wt % nrgp, h = (wt / nrgp) & 7, s = wt / (nrgp * 8), rg = rgp * 2 + (wave >> 2);
        const LAS float* tbh = tbl + h * 15 * 31;
        for (int pass = 0; pass < 2; ++pass) {
            const int i0 = rg * 8 + pass * 4;
            int rsj[4];
#pragma unroll
            for (int j = 0; j < 4; ++j) { int r_ = i0 + j - 4; r_ = r_ < 0 ? 0 : r_; r_ = r_ > rows - 8 ? rows - 8 : r_; rsj[j] = r_; }
            const int ka0 = rsj[0], ka1 = rsj[3] + 7;
            const size_t tok0 = (size_t)s * T;
            bf16x8 qf[4][2];
#pragma unroll
            for (int j = 0; j < 4; ++j) { const char* qb = (const char*)(proj + (tok0 + (size_t)(i0 + j) * 64 + q0) * PW + C_Q + h * 64); qf[j][0] = *(const bf16x8*)(qb + qlane); qf[j][1] = *(const bf16x8*)(qb + qlane + 64); }
            const char* kb = (const char*)(proj + (tok0 + cs) * PW + C_K + h * 64);
            const char* vb = (const char*)(vt + (size_t)(h * 64) * MC + tok0 + cs);
            f32x4 o[4][4]; float mrun[4], lrun[4];
#pragma unroll
            for (int j = 0; j < 4; ++j) { mrun[j] = -INFINITY; lrun[j] = 0.f;
#pragma unroll
                for (int dt = 0; dt < 4; ++dt) o[j][dt] = (f32x4){0.f, 0.f, 0.f, 0.f}; }
            bf16x8 kf[2][2]; v4u vf[4];
            { const char* kp = kb + (size_t)ka0 * 64 * PW * 2;
#pragma unroll
              for (int hf = 0; hf < 2; ++hf) { kf[hf][0] = *(const bf16x8*)(kp + (size_t)(4 * hf) * PW * 2 + klane); kf[hf][1] = *(const bf16x8*)(kp + (size_t)(4 * hf) * PW * 2 + klane + 64); }
            }
            for (int ka = ka0; ka <= ka1; ++ka) {
                bf16x8 kn[2][2];
#pragma unroll
                for (int hf = 0; hf < 2; ++hf) { kn[hf][0] = kf[hf][0]; kn[hf][1] = kf[hf][1]; }
                { const char* vp = vb + (size_t)ka * 64 * 2;
#pragma unroll
                  for (int dt = 0; dt < 4; ++dt) vf[dt] = *(const v4u*)(vp + (size_t)(16 * dt) * MC * 2 + vlane); }
                if (ka < ka1) { const char* kp = kb + (size_t)(ka + 1) * 64 * PW * 2;
#pragma unroll
                    for (int hf = 0; hf < 2; ++hf) { kn[hf][0] = *(const bf16x8*)(kp + (size_t)(4 * hf) * PW * 2 + klane); kn[hf][1] = *(const bf16x8*)(kp + (size_t)(4 * hf) * PW * 2 + klane + 64); } }
#pragma unroll
                for (int j = 0; j < 4; ++j) { const int kr = ka - rsj[j];
                    if (kr >= 0 && kr < 8) {
                        f32x4 st[2];
#pragma unroll
                        for (int hf = 0; hf < 2; ++hf) { const f32x4 t = __builtin_amdgcn_mfma_f32_16x16x32_bf16(kf[hf][0], qf[j][0], (f32x4){0.f, 0.f, 0.f, 0.f}, 0, 0, 0);
                            st[hf] = __builtin_amdgcn_mfma_f32_16x16x32_bf16(kf[hf][1], qf[j][1], t, 0, 0, 0); }
                        const LAS float* tb = tbh + (ka - i0 - j + 7) * 31;
                        float mloc = -INFINITY;
#pragma unroll
                        for (int hf = 0; hf < 2; ++hf)
#pragma unroll
                            for (int e = 0; e < 4; ++e) { const unsigned dc = ((hf == 0 ? dpack0 : dpack1) >> (8 * e)) & 0xffu; const float b = tb[dc];
                                const float v = ((vmask >> (hf * 4 + e)) & 1u) ? st[hf][e] * SC + b : -INFINITY; st[hf][e] = v; mloc = fmaxf(mloc, v); }
                        mloc = fmaxf(mloc, __shfl_xor(mloc, 16)); mloc = fmaxf(mloc, __shfl_xor(mloc, 32));
                        const float mnew = fmaxf(mrun[j], mloc), alpha = __builtin_amdgcn_exp2f(mrun[j] - mnew); mrun[j] = mnew;
                        float p[8], psum = 0.f;
#pragma unroll
                        for (int hf = 0; hf < 2; ++hf)
#pragma unroll
                            for (int e = 0; e < 4; ++e) { p[hf * 4 + e] = __builtin_amdgcn_exp2f(st[hf][e] - mnew); psum += p[hf * 4 + e]; }
                        lrun[j] = lrun[j] * alpha + psum;
                        v4u w; w.x = cvt_pk_bf16(p[0], p[1]); w.y = cvt_pk_bf16(p[2], p[3]); w.z = cvt_pk_bf16(p[4], p[5]); w.w = cvt_pk_bf16(p[6], p[7]);
                        const bf16x8 pk = __builtin_bit_cast(bf16x8, w);
#pragma unroll
                        for (int dt = 0; dt < 4; ++dt) o[j][dt] = __builtin_amdgcn_mfma_f32_16x16x32_bf16(__builtin_bit_cast(bf16x8, vf[dt]), pk, o[j][dt] * alpha, 0, 0, 0);
                    } }
#pragma unroll
                for (int hf = 0; hf < 2; ++hf) { kf[hf][0] = kn[hf][0]; kf[hf][1] = kn[hf][1]; }
            }
#pragma unroll
            for (int j = 0; j < 4; ++j) { float l = lrun[j]; l += __shfl_xor(l, 16); l += __shfl_xor(l, 32); const float inv = 1.0f / l;
                char* ob = (char*)(ya + (tok0 + (size_t)(i0 + j) * 64 + q0) * AW + h * 64);
#pragma unroll
                for (int dt = 0; dt < 4; ++dt) { v2u w; w.x = cvt_pk_bf16(o[j][dt][0] * inv, o[j][dt][1] * inv); w.y = cvt_pk_bf16(o[j][dt][2] * inv, o[j][dt][3] * inv); *(v2u*)(ob + olane + 32 * dt) = w; } }
        }
    }
}
#define XB_TMO      128
#define XB_XCNT(j)  (256  + 64 * (j))
#define XB_XSUB(j)  (1280 + 64 * (j))
#define XB_XGEN(j)  (2304 + 64 * (j))
#define XB_TOP      3328
#define XB_TOPGEN   3392
#define XCD_BAR_WORDS 3456
#define XB_SPIN_CAP (1u << 18)

__device__ __forceinline__ unsigned xb_ld(unsigned* p)              { return __hip_atomic_load(p, __ATOMIC_RELAXED, __HIP_MEMORY_SCOPE_AGENT); }
__device__ __forceinline__ unsigned xb_add(unsigned* p, unsigned v) { return __hip_atomic_fetch_add(p, v, __ATOMIC_RELAXED, __HIP_MEMORY_SCOPE_AGENT); }
__device__ __forceinline__ unsigned xb_xcc_id() { return (unsigned)__builtin_amdgcn_s_getreg((3 << 11) | 20) & 0xFu; }
#define XB_SPIN(cond, bar) do { unsigned _sp = 0; while (cond) { __builtin_amdgcn_s_sleep(1); \
    if ((++_sp & 255u) == 0u) { if (xb_ld(&(bar)[XB_TMO])) break; if (_sp > XB_SPIN_CAP) { atomicAdd(&(bar)[XB_TMO], 1u); break; } } } } while (0)

struct XcdBarrier {
    unsigned* bar; unsigned x;
    volatile LAS unsigned* st;
};

__device__ __forceinline__ XcdBarrier xcd_barrier_post(unsigned* bar, volatile LAS unsigned* st) {
    XcdBarrier b; b.bar = bar; b.x = xb_xcc_id(); b.st = st;
    if (threadIdx.x == 0) (void)xb_add(&bar[XB_XCNT(b.x)], 1u);
    return b;
}
__device__ __forceinline__ void xcd_barrier_complete(unsigned* bar, unsigned x, unsigned& nloc, unsigned& nx) {
    const unsigned G = gridDim.x * gridDim.y * gridDim.z;
    unsigned sum, cnt, mine, sp = 0u;
    for (;;) {
        sum = 0u; cnt = 0u; mine = 0u;
#pragma unroll
        for (unsigned j = 0; j < 16; ++j) { const unsigned c = xb_ld(&bar[XB_XCNT(j)]); sum += c; cnt += (c > 0u) ? 1u : 0u; mine = (j == x) ? c : mine; }
        if (sum == G) break;
        __builtin_amdgcn_s_sleep(1);
        if ((++sp & 255u) == 0u) { if (xb_ld(&bar[XB_TMO])) break; if (sp > XB_SPIN_CAP) { atomicAdd(&bar[XB_TMO], 1u); break; } }
    }
    nloc = mine > 0u ? mine : 1u; nx = cnt > 0u ? cnt : 1u;
}

__device__ __forceinline__ void xcd_barrier(const XcdBarrier& b) {
    asm volatile("s_waitcnt vmcnt(0)" ::: "memory");
    __syncthreads();
    if (threadIdx.x == 0) {
        unsigned* bar = b.bar;
        __builtin_amdgcn_s_waitcnt(0);
        unsigned nloc = b.st[0], nx = b.st[1];
        if (nloc == 0u) { xcd_barrier_complete(bar, b.x, nloc, nx); b.st[0] = nloc; b.st[1] = nx; }
        const unsigned old = xb_add(&bar[XB_XSUB(b.x)], 1u);
        const unsigned gen = old / nloc;
        if (old + 1u == (gen + 1u) * nloc) {
            __builtin_amdgcn_fence(__ATOMIC_RELEASE, "agent");
            asm volatile("s_waitcnt vmcnt(0)" ::: "memory");
            const unsigned og = xb_add(&bar[XB_TOP], 1u);
            const unsigned tg = og / nx;
            if (og + 1u == (tg + 1u) * nx) xb_add(&bar[XB_TOPGEN], 1u);
            else XB_SPIN(xb_ld(&bar[XB_TOPGEN]) == tg, bar);
            __builtin_amdgcn_fence(__ATOMIC_ACQUIRE, "agent");
            xb_add(&bar[XB_XGEN(b.x)], 1u);
            asm volatile("s_waitcnt vmcnt(0)" ::: "memory");
        } else {
            XB_SPIN(xb_ld(&bar[XB_XGEN(b.x)]) == gen, bar);
            __builtin_amdgcn_fence(__ATOMIC_ACQUIRE, "agent");
            asm volatile("s_waitcnt vmcnt(0)" ::: "memory");
        }
    }
    __syncthreads();
}
#define IN(i) ldin(a, i)
__global__ void __launch_bounds__(NTHR, 2) mega_fwd(Args a) {
    extern __shared__ __attribute__((aligned(16))) unsigned char lds_raw[];
    LAS unsigned char* lds = (LAS unsigned char*)lds_raw;
    cg::grid_group grid = cg::this_grid();
    const int tid = threadIdx.x, lane0 = tid & 63, wave0 = __builtin_amdgcn_readfirstlane(tid >> 6);
    const int G = gridDim.x, bx = blockIdx.x;
    const int vcu = (G % 8 == 0) ? (bx % 8) * (G / 8) + bx / 8 : bx;
    const int gw0 = vcu * NWAVES + wave0, NGW = G * NWAVES, gtid0 = vcu * NTHR + tid, NT = G * NTHR;
    unsigned char* ws = a.ws;
    bf16* XB = (bf16*)(ws + WS_XB); bf16* PROJ = (bf16*)(ws + WS_PROJ); bf16* VT = (bf16*)(ws + WS_VT); bf16* YA = (bf16*)(ws + WS_YA); bf16* YC = (bf16*)(ws + WS_YC);
    bf16* MG = (bf16*)(ws + WS_MG); bf16* HB = (bf16*)(ws + WS_H); bf16* GB = (bf16*)(ws + WS_G);
    int ph = 0;
    volatile LAS unsigned* bst = (volatile LAS unsigned*)(lds + 131072 + 64);
    if (tid < 2) bst[tid] = 0u;
    __syncthreads();
    XcdBarrier xbar = xcd_barrier_post((unsigned*)(ws + WS_BAR), bst);
#define SEAM() do { xcd_barrier(xbar); } while (0)
#define IDST idptr(ws, 0)
#define ONES idptr(ws, 2 * MC)
#define ZEROS idptr(ws, 2 * MC + DM)
#define STATS(ll, sub) ((float*)(ws + WS_ST) + (size_t)((chunk * NLAYER + (ll)) * 2 + (sub)) * MC * 2)

    prologue_weights(a, lds, gw0, NGW, wave0, lane0);
    convert_rows(IN(0), XB, MC, vcu, NGW);
    { float* idp = (float*)(ws + WS_ID);
      for (int i = gtid0; i < MC; i += NT) { idp[2 * i] = 0.f; idp[2 * i + 1] = 1024.0f * (1.0f - 1e-5f); }
      for (int i = gtid0; i < DM; i += NT) { idp[2 * MC + i] = 1.f; idp[2 * MC + DM + i] = 0.f; } }
    grid.sync();

    for (int chunk = 0; chunk < NCHUNK; ++chunk) {
        const float* xin = (chunk == 0) ? IN(0) : IN(1) + (size_t)(chunk - 1) * MC * DM;
        float* outc = a.out + (size_t)chunk * MC * DM;
        const int T = (chunk == 0) ? 8192 : 2048;
        for (int l = 0; l < NLAYER; ++l) {
            const bf16* wl = (const bf16*)(ws + WS_W) + (size_t)l * W_LAYER;
            const float* csl = (const float*)(ws + WS_CS) + (size_t)l * CS_LAYER;
            { pg8::Gemm g{XB, wl + OFF_WIN, MC, PW, DM, DM, DM, wl + OFF_WV, XB}; pg8::P1Order S; S.init(MC, PW, AW, MC, G, bx);
              const float* st_ = l > 0 ? STATS(l - 1, 1) : IDST;
              pg8::EpiP1Multi E{pg8::EpiLNP1{PROJ, PW, csl + CS_IN, csl + BC_IN, st_}, pg8::EpiLNT{VT, MC, csl + CS_IN + 1024, csl + BC_IN + 1024, st_}};
              pg8::gemm_phase<pg8::EpiP1Multi, pg8::P1Order, true, true>(lds, g, S, E); }
            SEAM();
            attn_phase(PROJ, VT, YA, IN(4) + (size_t)l * 8 * 15 * 31, T, vcu, G, lds);
            convbranch_phase(PROJ, YC, IN(5) + (size_t)l * 3 * AW, IN(6) + (size_t)l * AW, T, vcu, NT);
            SEAM();
            { pg8::Gemm g{YA, wl + OFF_WA, MC, DM, AW, AW, AW, YC, wl + OFF_WC}; pg8::PairedOrder S; S.init(MC, DM, G, bx);
              pg8::EpiGateDual E{MG, DM, PROJ + C_GA, PROJ + C_GCC, PW};
              pg8::gemm_phase<pg8::EpiGateDual, pg8::PairedOrder, true, true>(lds, g, S, E); }
            SEAM();
            { pg8::Gemm g{MG, wl + OFF_WO, MC, DM, DM, DM, DM}; pg8::StaticOrder S; S.init(MC, DM, G, bx);
              pg8::EpiRes2 E{(l == 0) ? xin : outc, outc, XB, DM, IN(10) + (size_t)l * DM, l > 0 ? STATS(l - 1, 1) : IDST,
                             l > 0 ? IN(19) + (size_t)(l - 1) * DM : ONES, l > 0 ? IN(20) + (size_t)(l - 1) * DM : ZEROS, STATS(l, 0)};
              pg8::gemm_phase<pg8::EpiRes2, pg8::StaticOrder, true, true>(lds, g, S, E); }
            SEAM();
            { pg8::Gemm g{XB, wl + OFF_WUP, MC, NUP, DM, DM, DM}; pg8::StaticOrder S; S.init(MC, NUP, G, bx);
              pg8::EpiLN E{HB, NUP, csl + CS_UP, csl + BC_UP, 1 << 30, 0, STATS(l, 0)};
              pg8::gemm_phase<pg8::EpiLN, pg8::StaticOrder, true, true>(lds, g, S, E); }
            SEAM();
            ffnconv_phase(HB, GB, IN(15) + (size_t)l * 3 * NUP, IN(16) + (size_t)l * NUP, T, vcu, NT);
            if (l + 1 == NLAYER && chunk + 1 < NCHUNK) convert_rows(IN(1) + (size_t)chunk * MC * DM, XB, MC, vcu, NGW);
            SEAM();
            { pg8::Gemm g{GB, wl + OFF_WDN, MC, DM, DFF, DFF, DFF}; pg8::StaticOrder S; S.init(MC, DM, G, bx);
              pg8::EpiRes2 E{outc, outc, (l + 1 < NLAYER) ? XB : nullptr, DM, IN(18) + (size_t)l * DM, STATS(l, 0), IN(11) + (size_t)l * DM, IN(12) + (size_t)l * DM, STATS(l, 1)};
              pg8::gemm_phase<pg8::EpiRes2, pg8::StaticOrder, true, true>(lds, g, S, E); }
            SEAM();
            if (l + 1 == NLAYER) {
                ln_rows(outc, XB, IN(19) + (size_t)l * DM, IN(20) + (size_t)l * DM, MC, vcu, NGW, false);
            }
        }
    }
    (void)ph;
}

extern "C" void kernel_launch(void* const* d_in, const int* in_sizes, int n_in, void* d_out, int out_size, void* d_ws, size_t ws_size, hipStream_t stream) {
    static int grid = 0;
    if (grid == 0) {
        if (n_in != 21 || out_size != NCHUNK * MC * DM || ws_size < WS_END) { fprintf(stderr, "kernel_launch: unexpected shapes: n_in %d out %d ws %zu\n", n_in, out_size, ws_size); grid = -1; return; }
        int dev = 0, cus = 0, per_cu = 0;
        if (hipGetDevice(&dev) != hipSuccess || hipDeviceGetAttribute(&cus, hipDeviceAttributeMultiprocessorCount, dev) != hipSuccess) { grid = -1; return; }
        if (hipFuncSetAttribute((const void*)mega_fwd, hipFuncAttributeMaxDynamicSharedMemorySize, LDS_BYTES) != hipSuccess) { fprintf(stderr, "kernel_launch: hipFuncSetAttribute failed\n"); grid = -1; return; }
        if (hipOccupancyMaxActiveBlocksPerMultiprocessor(&per_cu, (const void*)mega_fwd, NTHR, LDS_BYTES) != hipSuccess || per_cu < 1) { fprintf(stderr, "kernel_launch: occupancy query says %d\n", per_cu); per_cu = 1; }
        (void)hipGetLastError();
        grid = cus;
    }
    if (grid < 0) return;
    if (hipMemsetAsync((char*)d_ws + WS_ZERO, 0, ZERO_BYTES, stream) != hipSuccess) { fprintf(stderr, "kernel_launch: memset failed\n"); return; }
    Args a{};
    for (int i = 0; i < 21; ++i) a.in[i] = (const float*)d_in[i];
    a.out = (float*)d_out; a.ws = (unsigned char*)d_ws; a.ph_lo = 0; a.ph_hi = 0;
    void* args[] = {&a};
    hipError_t e = hipLaunchCooperativeKernel((const void*)mega_fwd, dim3(grid), dim3(NTHR), args, LDS_BYTES, stream);
    if (e != hipSuccess) fprintf(stderr, "kernel_launch: cooperative launch failed: %s (grid %d)\n", hipGetErrorString(e), grid);
}
```
